# Optimizing an MI355X kernel written in HIP

```python
import math
import jax, jax.numpy as jnp
from jax import lax
import numpy as np

D_MODEL = 1024
BATCH = 2
SEQ = 8192
DEPTH = 4

GRID_W = 64
CTX_LEN = 256
N_HEADS = 4
HEAD_DIM = 64
V_DIM = 2 * HEAD_DIM
QK_WIDTH = N_HEADS * 2 * HEAD_DIM
ATTN_WIDTH = N_HEADS * V_DIM
SSM_WIDTH = D_MODEL // 4
SSM_P = 16
SSM_G = SSM_WIDTH // SSM_P
SSM_N = 64
FNET_WIDTH = D_MODEL // 4
FNET_G = 4
FNET_C = FNET_WIDTH // FNET_G
MIX_WIDTH = ATTN_WIDTH + SSM_WIDTH + FNET_WIDTH
IN_WIDTH = 2 * QK_WIDTH + ATTN_WIDTH + SSM_WIDTH + FNET_WIDTH
D_FF = 4 * D_MODEL
Q_BLOCK = 128
ROPE_BASE = 10000.0
EPS = 1e-6

kernel_name = 'hybrid_diffattn_s5_fnet_dit_block'


def rms_norm(x, g):
    xf = x.astype(jnp.float32)
    y = xf * lax.rsqrt(jnp.mean(xf * xf, axis=-1, keepdims=True) + EPS)
    return (y * g.astype(jnp.float32)).astype(x.dtype)


def axial_rope_tables(n_tokens):
    rows = n_tokens // GRID_W
    t = jnp.arange(rows * GRID_W)
    row = (t // GRID_W).astype(jnp.float32)
    col = (t % GRID_W).astype(jnp.float32)
    n_freq = HEAD_DIM // 4
    inv = jnp.power(ROPE_BASE, -jnp.arange(n_freq, dtype=jnp.float32) / n_freq)
    ang = jnp.concatenate([row[:, None] * inv, col[:, None] * inv], axis=-1)
    return jnp.cos(ang), jnp.sin(ang)


def apply_rope(x, cos, sin):
    half = x.shape[-1] // 2
    x1 = x[..., :half].astype(jnp.float32)
    x2 = x[..., half:].astype(jnp.float32)
    cos = cos[None, :, None, None, :]
    sin = sin[None, :, None, None, :]
    return jnp.concatenate([x1 * cos - x2 * sin, x2 * cos + x1 * sin], axis=-1).astype(x.dtype)


def diff_attention(q, k, v, lam):
    b, lq, h, _, dh = q.shape
    nb = lq // Q_BLOCK
    qb = jnp.moveaxis(q.reshape(b, nb, Q_BLOCK, h, 2, dh), 1, 0)
    scale = dh ** -0.5

    def one_block(qblk):
        s = jnp.einsum('bqhmd,bkhmd->bmhqk', qblk, k).astype(jnp.float32) * scale
        p = jax.nn.softmax(s, axis=-1)
        w = p[:, 0] - lam * p[:, 1]
        return jnp.einsum('bhqk,bkhd->bqhd', w.astype(v.dtype), v)

    out = lax.map(one_block, qb)
    return jnp.moveaxis(out, 0, 1).reshape(b, lq, h, v.shape[-1])


def zoh_discretise(a_re, a_im, log_dt, b_re, b_im):
    f32 = jnp.float32
    a_re = a_re.astype(f32)
    a_im = a_im.astype(f32)
    dt = jnp.exp(log_dt.astype(f32))[:, None]
    mag = jnp.exp(dt * a_re)
    ab_re = mag * jnp.cos(dt * a_im)
    ab_im = mag * jnp.sin(dt * a_im)
    den = a_re * a_re + a_im * a_im
    n_re = ab_re - 1.0
    f_re = (n_re * a_re + ab_im * a_im) / den
    f_im = (ab_im * a_re - n_re * a_im) / den
    b_re = b_re.astype(f32)
    b_im = b_im.astype(f32)
    bb_re = f_re[..., None] * b_re - f_im[..., None] * b_im
    bb_im = f_re[..., None] * b_im + f_im[..., None] * b_re
    return ab_re, ab_im, bb_re, bb_im


def _affine_combine(e1, e2):
    a1r, a1i, b1r, b1i = e1
    a2r, a2i, b2r, b2i = e2
    return (a2r * a1r - a2i * a1i,
            a2r * a1i + a2i * a1r,
            a2r * b1r - a2i * b1i + b2r,
            a2r * b1i + a2i * b1r + b2i)


def s5_scan(u, disc, s0, reverse):
    ab_re, ab_im, bb_re, bb_im = disc
    b, l, _ = u.shape
    uf = u.astype(jnp.float32).reshape(b, l, SSM_G, SSM_P)
    if reverse:
        uf = uf[:, ::-1]
    bu_re = jnp.einsum('blgp,gnp->blgn', uf, bb_re)
    bu_im = jnp.einsum('blgp,gnp->blgn', uf, bb_im)
    if s0 is not None:
        s0_re, s0_im = s0
        bu_re = bu_re.at[:, 0].add(ab_re * s0_re - ab_im * s0_im)
        bu_im = bu_im.at[:, 0].add(ab_re * s0_im + ab_im * s0_re)
    a_re = jnp.broadcast_to(ab_re, bu_re.shape)
    a_im = jnp.broadcast_to(ab_im, bu_im.shape)
    _, _, s_re, s_im = lax.associative_scan(_affine_combine, (a_re, a_im, bu_re, bu_im), axis=1)
    return s_re, s_im


def s5_readout(states, c_re, c_im, reverse):
    s_re, s_im = states
    y = (jnp.einsum('blgn,gpn->blgp', s_re, c_re.astype(jnp.float32))
         - jnp.einsum('blgn,gpn->blgp', s_im, c_im.astype(jnp.float32)))
    if reverse:
        y = y[:, ::-1]
    b, l = y.shape[:2]
    return y.reshape(b, l, SSM_WIDTH)


def s5_glu(y, p):
    h = jax.nn.gelu(y)
    return h * jax.nn.sigmoid(h @ p['w_glu'] + p['b_glu'])


def s5_mixer(u_x, u_c, p, ctx_out):
    d_skip = p['ssm_d'].astype(jnp.float32)
    y_x = d_skip * u_x.astype(jnp.float32)
    y_c = d_skip * u_c.astype(jnp.float32) if ctx_out else None
    for direction in range(2):
        rev = direction == 1
        disc = zoh_discretise(p['ssm_a_re'][direction], p['ssm_a_im'][direction],
                              p['ssm_log_dt'][direction], p['ssm_b_re'][direction],
                              p['ssm_b_im'][direction])
        st_c = s5_scan(u_c, disc, None, rev)
        st_x = s5_scan(u_x, disc, (st_c[0][:, -1], st_c[1][:, -1]), rev)
        y_x = y_x + s5_readout(st_x, p['ssm_c_re'][direction], p['ssm_c_im'][direction], rev)
        if ctx_out:
            y_c = y_c + s5_readout(st_c, p['ssm_c_re'][direction], p['ssm_c_im'][direction], rev)
    out_x = s5_glu(y_x.astype(u_x.dtype), p)
    out_c = s5_glu(y_c.astype(u_c.dtype), p) if ctx_out else None
    return out_x, out_c


def fourier_mix(h, w_fnet):
    b, l, _ = h.shape
    hf = h.astype(jnp.float32).reshape(b, l, FNET_G, FNET_C)
    z = jnp.fft.fftn(hf, axes=(1, 3), norm='ortho').real.astype(h.dtype)
    return jnp.einsum('blgc,gcd->blgd', z, w_fnet).reshape(b, l, FNET_WIDTH)


def sq_relu_mlp(h, p):
    return jnp.square(jax.nn.relu(h @ p['w_ff1'])) @ p['w_ff2']


def split_proj(proj):
    b, l, _ = proj.shape
    o1 = QK_WIDTH
    o2 = 2 * QK_WIDTH
    o3 = o2 + ATTN_WIDTH
    o4 = o3 + SSM_WIDTH
    q = proj[..., :o1].reshape(b, l, N_HEADS, 2, HEAD_DIM)
    k = proj[..., o1:o2].reshape(b, l, N_HEADS, 2, HEAD_DIM)
    v = proj[..., o2:o3].reshape(b, l, N_HEADS, V_DIM)
    return q, k, v, proj[..., o3:o4], proj[..., o4:]


def trunk_layer(x, ctx, c_act, cctx_act, rope, p, layer_idx, ctx_out):
    cos, sin = rope
    b, l, _ = x.shape
    bc, lc, _ = ctx.shape
    mod_x = (c_act @ p['w_mod'] + p['b_mod'])[:, None, :]
    mod_c = (cctx_act @ p['w_mod'] + p['b_mod'])[None, None, :]
    sh1x, sc1x, g1x, sh2x, sc2x, g2x = jnp.split(mod_x, 6, axis=-1)
    sh1c, sc1c, g1c, sh2c, sc2c, g2c = jnp.split(mod_c, 6, axis=-1)

    hx = rms_norm(x, p['g_norm1']) * (1.0 + sc1x) + sh1x
    hc = rms_norm(ctx, p['g_norm1']) * (1.0 + sc1c) + sh1c
    qx, kx, vx, ux, fx = split_proj(hx @ p['w_in'])
    qc, kc, vc, uc, fc = split_proj(hc @ p['w_in'])

    f32 = jnp.float32
    lam_init = 0.8 - 0.6 * math.exp(-0.3 * layer_idx)
    lam = (jnp.exp(jnp.sum(p['lam_q1'].astype(f32) * p['lam_k1'].astype(f32)))
           - jnp.exp(jnp.sum(p['lam_q2'].astype(f32) * p['lam_k2'].astype(f32))) + lam_init)
    qx = apply_rope(rms_norm(qx, p['g_qnorm']), cos, sin)
    kx = apply_rope(rms_norm(kx, p['g_knorm']), cos, sin)
    kc = rms_norm(kc, p['g_knorm'])
    k_all = jnp.concatenate([kc, kx], axis=1)
    v_all = jnp.concatenate([vc, vx], axis=1)
    ax = rms_norm(diff_attention(qx, k_all, v_all, lam), p['g_subln']) * (1.0 - lam_init)

    sx, sc = s5_mixer(ux, uc, p, ctx_out)

    mix_x = jnp.concatenate([ax.reshape(b, l, ATTN_WIDTH), sx, fourier_mix(fx, p['w_fnet'])], axis=-1)
    x = x + g1x * (mix_x @ p['w_out'])

    x = x + g2x * sq_relu_mlp(rms_norm(x, p['g_norm2']) * (1.0 + sc2x) + sh2x, p)

    if ctx_out:
        qc = rms_norm(qc, p['g_qnorm'])
        ac = rms_norm(diff_attention(qc, kc, vc, lam), p['g_subln']) * (1.0 - lam_init)
        mix_c = jnp.concatenate([ac.reshape(bc, lc, ATTN_WIDTH), sc, fourier_mix(fc, p['w_fnet'])], axis=-1)
        ctx = ctx + g1c * (mix_c @ p['w_out'])
        ctx = ctx + g2c * sq_relu_mlp(rms_norm(ctx, p['g_norm2']) * (1.0 + sc2c) + sh2c, p)
    return x, ctx


def setup_inputs(seed: int = 0) -> dict:
    key = jax.random.key(seed)
    ks = jax.random.split(key, 32)
    f32 = jnp.float32

    def nrm(k, shape, s):
        return jax.random.normal(k, shape, f32) * s

    n_idx = jnp.arange(SSM_N, dtype=f32)
    return {
        'x': nrm(ks[0], (BATCH, SEQ, D_MODEL), 1.0),
        'c': nrm(ks[1], (BATCH, D_MODEL), 1.0),
        'ctx': nrm(ks[2], (BATCH, CTX_LEN, D_MODEL), 1.0),
        'c_ctx': nrm(ks[3], (D_MODEL,), 1.0),
        'w_mod': nrm(ks[4], (DEPTH, D_MODEL, 6 * D_MODEL), 0.5 * D_MODEL ** -0.5),
        'b_mod': nrm(ks[5], (DEPTH, 6 * D_MODEL), 0.02),
        'g_norm1': 1.0 + nrm(ks[6], (DEPTH, D_MODEL), 0.02),
        'w_in': nrm(ks[7], (DEPTH, D_MODEL, IN_WIDTH), D_MODEL ** -0.5),
        'g_qnorm': 1.0 + nrm(ks[8], (DEPTH, HEAD_DIM), 0.02),
        'g_knorm': 1.0 + nrm(ks[9], (DEPTH, HEAD_DIM), 0.02),
        'lam_q1': nrm(ks[10], (DEPTH, HEAD_DIM), 0.1),
        'lam_k1': nrm(ks[11], (DEPTH, HEAD_DIM), 0.1),
        'lam_q2': nrm(ks[12], (DEPTH, HEAD_DIM), 0.1),
        'lam_k2': nrm(ks[13], (DEPTH, HEAD_DIM), 0.1),
        'g_subln': 1.0 + nrm(ks[14], (DEPTH, V_DIM), 0.02),
        'ssm_a_re': -0.5 + nrm(ks[15], (DEPTH, 2, SSM_G, SSM_N), 0.01),
        'ssm_a_im': jnp.pi * n_idx + nrm(ks[16], (DEPTH, 2, SSM_G, SSM_N), 0.01),
        'ssm_log_dt': jax.random.uniform(ks[17], (DEPTH, 2, SSM_G), f32,
                                         minval=math.log(1e-3), maxval=math.log(1e-1)),
        'ssm_b_re': nrm(ks[18], (DEPTH, 2, SSM_G, SSM_N, SSM_P), (2 * SSM_P) ** -0.5),
        'ssm_b_im': nrm(ks[19], (DEPTH, 2, SSM_G, SSM_N, SSM_P), (2 * SSM_P) ** -0.5),
        'ssm_c_re': nrm(ks[20], (DEPTH, 2, SSM_G, SSM_P, SSM_N), 0.5),
        'ssm_c_im': nrm(ks[21], (DEPTH, 2, SSM_G, SSM_P, SSM_N), 0.5),
        'ssm_d': nrm(ks[22], (DEPTH, SSM_WIDTH), 0.5),
        'w_glu': nrm(ks[23], (DEPTH, SSM_WIDTH, SSM_WIDTH), SSM_WIDTH ** -0.5),
        'b_glu': nrm(ks[24], (DEPTH, SSM_WIDTH), 0.02),
        'w_fnet': nrm(ks[25], (DEPTH, FNET_G, FNET_C, FNET_C), FNET_C ** -0.5),
        'w_out': nrm(ks[26], (DEPTH, MIX_WIDTH, D_MODEL), MIX_WIDTH ** -0.5),
        'g_norm2': 1.0 + nrm(ks[27], (DEPTH, D_MODEL), 0.02),
        'w_ff1': nrm(ks[28], (DEPTH, D_MODEL, D_FF), D_MODEL ** -0.5),
        'w_ff2': nrm(ks[29], (DEPTH, D_FF, D_MODEL), D_FF ** -0.5),
    }


def reference(x, c, ctx, c_ctx, w_mod, b_mod, g_norm1, w_in, g_qnorm, g_knorm,
              lam_q1, lam_k1, lam_q2, lam_k2, g_subln, ssm_a_re, ssm_a_im, ssm_log_dt,
              ssm_b_re, ssm_b_im, ssm_c_re, ssm_c_im, ssm_d, w_glu, b_glu, w_fnet,
              w_out, g_norm2, w_ff1, w_ff2):
    rope = axial_rope_tables(x.shape[1])
    c_act = jax.nn.silu(c)
    cctx_act = jax.nn.silu(c_ctx)
    for i in range(DEPTH):
        p = {
            'w_mod': w_mod[i], 'b_mod': b_mod[i], 'g_norm1': g_norm1[i], 'w_in': w_in[i],
            'g_qnorm': g_qnorm[i], 'g_knorm': g_knorm[i],
            'lam_q1': lam_q1[i], 'lam_k1': lam_k1[i], 'lam_q2': lam_q2[i], 'lam_k2': lam_k2[i],
            'g_subln': g_subln[i],
            'ssm_a_re': ssm_a_re[i], 'ssm_a_im': ssm_a_im[i], 'ssm_log_dt': ssm_log_dt[i],
            'ssm_b_re': ssm_b_re[i], 'ssm_b_im': ssm_b_im[i],
            'ssm_c_re': ssm_c_re[i], 'ssm_c_im': ssm_c_im[i], 'ssm_d': ssm_d[i],
            'w_glu': w_glu[i], 'b_glu': b_glu[i], 'w_fnet': w_fnet[i], 'w_out': w_out[i],
            'g_norm2': g_norm2[i], 'w_ff1': w_ff1[i], 'w_ff2': w_ff2[i],
        }
        x, ctx = trunk_layer(x, ctx, c_act, cctx_act, rope, p, i, i < DEPTH - 1)
    return x
```

```cpp
#include <hip/hip_runtime.h>
#include <hip/hip_cooperative_groups.h>
#include <cstdio>
#include <cstdint>
namespace cg = cooperative_groups;

#ifndef COOP
#define COOP 1
#endif

#define DI __device__ __forceinline__
typedef unsigned short u16;
typedef short bf16x8 __attribute__((ext_vector_type(8)));
typedef float f32x4 __attribute__((ext_vector_type(4)));
typedef float f32x16 __attribute__((ext_vector_type(16)));
typedef __bf16 bf16v2 __attribute__((ext_vector_type(2)));
typedef float f32v2 __attribute__((ext_vector_type(2)));

constexpr int DM = 1024, NBATCH = 2, SEQ = 8192, DEPTH = 4, CTX = 256;
constexpr int XTOK = NBATCH * SEQ;
constexpr int NTOK = XTOK + NBATCH * CTX;
constexpr int LK = CTX + SEQ;
constexpr int NKT = LK / 32;
constexpr int NCH = LK / 32;
constexpr int DFF = 4096;
constexpr int LDS_BYTES = 77824;
constexpr float EPS = 1e-6f;
constexpr float LOG2E = 1.4426950408889634f;

constexpr size_t AL(size_t x) { return (x + 255) & ~(size_t)255; }
constexpr size_t OFF_WIN = 0;
constexpr size_t OFF_WOUT = OFF_WIN + AL((size_t)DEPTH * 2048 * 1024 * 2);
constexpr size_t OFF_WFF1 = OFF_WOUT + AL((size_t)DEPTH * 1024 * 1024 * 2);
constexpr size_t OFF_WFF2 = OFF_WFF1 + AL((size_t)DEPTH * 4096 * 1024 * 2);
constexpr size_t OFF_WGLU = OFF_WFF2 + AL((size_t)DEPTH * 4096 * 1024 * 2);
constexpr size_t OFF_XBUF = OFF_WGLU + AL((size_t)DEPTH * 256 * 256 * 2);
constexpr size_t OFF_MIX = OFF_XBUF + AL((size_t)NTOK * 1024 * 4);
constexpr size_t OFF_MOD = OFF_MIX + AL((size_t)NTOK * 1024 * 2);
constexpr size_t OFF_SMALL = OFF_MOD + AL((size_t)DEPTH * 3 * 6144 * 4);
constexpr size_t OFF_AB = OFF_SMALL + 256;
constexpr size_t OFF_AT = OFF_AB + AL((size_t)DEPTH * 2 * 16 * 64 * 2 * 4);
constexpr size_t OFF_BBAR = OFF_AT + AL((size_t)DEPTH * 2 * 16 * 64 * 2 * 4);
constexpr size_t OFF_CM = OFF_BBAR + AL((size_t)DEPTH * 2 * 16 * 64 * 32 * 4);
constexpr size_t OFF_ROPE = OFF_CM + AL((size_t)DEPTH * 2 * 16 * 16 * 128 * 2);
constexpr size_t OFF_D128 = OFF_ROPE + AL((size_t)192 * 16 * 8);
constexpr size_t OFF_D64 = OFF_D128 + AL((size_t)256 * 128 * 2);
constexpr size_t OFF_TW = OFF_D64 + AL((size_t)128 * 128 * 2);
constexpr size_t OFF_WCS = OFF_TW + AL((size_t)128 * 64 * 8);
constexpr size_t OFF_R1 = OFF_WCS + AL((size_t)DEPTH * 4 * 64 * 128 * 2);
constexpr size_t OFF_HID = OFF_R1;
constexpr size_t OFF_Q = OFF_R1;
constexpr size_t OFF_QC = OFF_Q + AL((size_t)2 * 4 * 2 * 8192 * 64 * 2);
constexpr size_t OFF_K = OFF_QC + AL((size_t)2 * 4 * 2 * 256 * 64 * 2);
constexpr size_t OFF_VT = OFF_K + AL((size_t)2 * 4 * 2 * LK * 64 * 2);
constexpr size_t OFF_U = OFF_VT + AL((size_t)2 * 4 * LK * 128 * 2);
constexpr size_t OFF_F = OFF_U + AL((size_t)NTOK * 256 * 4);
constexpr size_t OFF_LOCAL = OFF_F + AL((size_t)NTOK * 256 * 4);
constexpr size_t OFF_CARRY = OFF_LOCAL + AL((size_t)2 * 2 * NCH * 1024 * 8);
constexpr size_t OFF_T = OFF_CARRY + AL((size_t)2 * 2 * NCH * 1024 * 8);
constexpr size_t OFF_HGLU = OFF_T + AL((size_t)2 * 4 * 128 * 2 * 64 * 64 * 4);
constexpr size_t OFF_END_MIX = OFF_HGLU + AL((size_t)NTOK * 256 * 2);
constexpr size_t OFF_END_HID = OFF_HID + AL((size_t)NTOK * 4096 * 2);
constexpr size_t OFF_XCTX2 = OFF_END_MIX > OFF_END_HID ? OFF_END_MIX : OFF_END_HID;
constexpr size_t OFF_HN = OFF_XCTX2 + AL((size_t)NBATCH * CTX * 1024 * 4);
constexpr size_t OFF_BAR = OFF_HN + AL((size_t)NTOK * 1024 * 2);
constexpr size_t BAR_BYTES = 3456 * 4;
constexpr size_t OFF_BBH = OFF_BAR + AL(BAR_BYTES);
constexpr size_t WS_NEED = OFF_BBH + AL((size_t)DEPTH * 2 * 16 * 128 * 16 * 2);

struct P {
  const float *x, *c, *ctx, *c_ctx, *w_mod, *b_mod, *g_norm1, *w_in, *g_qnorm, *g_knorm, *lam_q1, *lam_k1, *lam_q2, *lam_k2,
      *g_subln, *ssm_a_re, *ssm_a_im, *ssm_log_dt, *ssm_b_re, *ssm_b_im, *ssm_c_re, *ssm_c_im, *ssm_d, *w_glu, *b_glu, *w_fnet,
      *w_out, *g_norm2, *w_ff1, *w_ff2;
  float* out;
  char* ws;
};

DI unsigned pk2(float a, float b) { f32v2 v = {a, b}; return __builtin_bit_cast(unsigned, __builtin_convertvector(v, bf16v2)); }
DI u16 bf1(float a) { return (u16)(pk2(a, 0.f) & 0xffffu); }
DI float bf2f(u16 h) { return __uint_as_float(((unsigned)h) << 16); }
DI f32x4 mfma16(bf16x8 a, bf16x8 b, f32x4 c) { return __builtin_amdgcn_mfma_f32_16x16x32_bf16(a, b, c, 0, 0, 0); }
DI f32x16 mfma32(bf16x8 a, bf16x8 b, f32x16 c) { return __builtin_amdgcn_mfma_f32_32x32x16_bf16(a, b, c, 0, 0, 0); }
DI float silu(float v) { return v / (1.f + __expf(-v)); }
DI float gelu_tanh(float v) { float t = 0.7978845608028654f * (v + 0.044715f * v * v * v); return 0.5f * v * (1.f + tanhf(t)); }
DI int get_tid() { int t = threadIdx.x & 255; asm volatile("" : "+v"(t)); return t; }
DI void opaque_zero2(float& a, float& b) { asm volatile("v_mov_b32 %0, 0\n\tv_mov_b32 %1, 0" : "=v"(a), "=v"(b)); }
DI float* xa_tile(const P& p, int mt) { return (float*)(p.ws + OFF_XBUF) + (size_t)mt * 128 * 1024; }
DI const float* xa_rd_tile(const P& p, int layer, int mt) {
  if (layer == 0) return mt < 128 ? p.x + (size_t)mt * 128 * 1024 : p.ctx + (size_t)(mt - 128) * 128 * 1024;
  return (const float*)(p.ws + OFF_XBUF) + (size_t)mt * 128 * 1024;
}
DI float* xb_tile(const P& p, int mt) { return mt < 128 ? p.out + (size_t)mt * 128 * 1024 : (float*)(p.ws + OFF_XCTX2) + (size_t)(mt - 128) * 128 * 1024; }
DI float lam_init_of(int layer) { return 0.8f - 0.6f * expf(-0.3f * (float)layer); }

DI void tr_unit(const float* __restrict__ src, u16* __restrict__ dst, int K, int N, int u, char* smem) {
  float* t = (float*)smem;
  const int tid = get_tid();
  const int tnN = N / 64, tk = u / tnN, tn = u % tnN;
  __syncthreads();
#pragma unroll
  for (int i = 0; i < 4; ++i) {
    const int k = (tid >> 4) + 16 * i, n4 = (tid & 15) * 4;
    *(float4*)(t + k * 68 + n4) = *(const float4*)(src + (size_t)(tk * 64 + k) * N + tn * 64 + n4);
  }
  __syncthreads();
#pragma unroll
  for (int i = 0; i < 2; ++i) {
    const int item = tid + 256 * i, n = item >> 3, kb = (item & 7) * 8;
    const float* tp = t + kb * 68 + n;
    uint4 o;
    o.x = pk2(tp[0], tp[68]); o.y = pk2(tp[2 * 68], tp[3 * 68]); o.z = pk2(tp[4 * 68], tp[5 * 68]); o.w = pk2(tp[6 * 68], tp[7 * 68]);
    *(uint4*)(dst + (size_t)(tn * 64 + n) * K + tk * 64 + kb) = o;
  }
}

DI void prep_transposes(const P& p, int u, char* smem) {
  const int l = u / 2832; int r = u % 2832;
  char* ws = p.ws;
  if (r < 512) { tr_unit(p.w_in + (size_t)l * 1024 * 2048, (u16*)(ws + OFF_WIN) + (size_t)l * 2048 * 1024, 1024, 2048, r, smem); return; }
  r -= 512;
  if (r < 256) { tr_unit(p.w_out + (size_t)l * 1024 * 1024, (u16*)(ws + OFF_WOUT) + (size_t)l * 1024 * 1024, 1024, 1024, r, smem); return; }
  r -= 256;
  if (r < 1024) { tr_unit(p.w_ff1 + (size_t)l * 1024 * 4096, (u16*)(ws + OFF_WFF1) + (size_t)l * 4096 * 1024, 1024, 4096, r, smem); return; }
  r -= 1024;
  if (r < 1024) { tr_unit(p.w_ff2 + (size_t)l * 4096 * 1024, (u16*)(ws + OFF_WFF2) + (size_t)l * 1024 * 4096, 4096, 1024, r, smem); return; }
  r -= 1024;
  tr_unit(p.w_glu + (size_t)l * 256 * 256, (u16*)(ws + OFF_WGLU) + (size_t)l * 256 * 256, 256, 256, r, smem);
}

DI void prep_copy(const P& p, int u) {
  float4* dst = (float4*)(p.ws + OFF_XBUF);
  const float4* sx = (const float4*)p.x; const float4* sc = (const float4*)p.ctx;
  const size_t nx4 = (size_t)XTOK * 256;
const int tid = get_tid();
#pragma unroll 4
  for (int i = 0; i < 16; ++i) {
    const size_t idx = (size_t)u * 4096 + i * 256 + tid;
    dst[idx] = idx < nx4 ? sx[idx] : sc[idx - nx4];
  }
}

DI void prep_mod(const P& p, int u, char* smem) {
  float* act = (float*)smem;
  float* red = act + 3072;
  const int tid = get_tid();
  const int l = u / 96, jb = u % 96;
  __syncthreads();
  for (int i = tid; i < 3072; i += 256) {
    const int r = i >> 10, k = i & 1023;
    const float v = r < 2 ? p.c[r * 1024 + k] : p.c_ctx[k];
    act[i] = silu(v);
  }
  __syncthreads();
  const int j = jb * 64 + (tid & 63), kg = tid >> 6;
  float a0 = 0.f, a1 = 0.f, a2 = 0.f;
  const float* wp = p.w_mod + (size_t)l * 1024 * 6144 + j;
#pragma unroll 32
  for (int k = kg * 256; k < kg * 256 + 256; ++k) {
    const float wv = wp[(size_t)k * 6144];
    a0 += act[k] * wv; a1 += act[1024 + k] * wv; a2 += act[2048 + k] * wv;
  }
  red[(kg * 3 + 0) * 64 + (tid & 63)] = a0; red[(kg * 3 + 1) * 64 + (tid & 63)] = a1; red[(kg * 3 + 2) * 64 + (tid & 63)] = a2;
  __syncthreads();
  if (tid < 192) {
    const int r = tid >> 6, jj = tid & 63;
    float s = p.b_mod[l * 6144 + jb * 64 + jj];
    for (int q = 0; q < 4; ++q) s += red[(q * 3 + r) * 64 + jj];
    ((float*)(p.ws + OFF_MOD))[((size_t)l * 3 + r) * 6144 + jb * 64 + jj] = s;
  }
}

DI void prep_disc(const P& p, int u) {
  const int idx = u * 256 + get_tid();
  const int g = (idx >> 6) & 15;
  const int ld = idx >> 10;
  const float are = p.ssm_a_re[idx], aim = p.ssm_a_im[idx];
  const float dt = expf(p.ssm_log_dt[ld * 16 + g]);
  const float mag = expf(dt * are);
  const float abr = mag * cosf(dt * aim), abi = mag * sinf(dt * aim);
  const float den = are * are + aim * aim, nre = abr - 1.f;
  const float fre = (nre * are + abi * aim) / den, fim = (abi * are - nre * aim) / den;
  float2* AB = (float2*)(p.ws + OFF_AB); float2* AT = (float2*)(p.ws + OFF_AT);
  AB[idx] = make_float2(abr, abi);
  float tr = abr, ti = abi;
#pragma unroll
  for (int i = 0; i < 5; ++i) { const float nr = tr * tr - ti * ti, ni = 2.f * tr * ti; tr = nr; ti = ni; }
  AT[idx] = make_float2(tr, ti);
  float* bb = (float*)(p.ws + OFF_BBAR) + (size_t)idx * 32;
  const float* bre = p.ssm_b_re + (size_t)idx * 16; const float* bim = p.ssm_b_im + (size_t)idx * 16;
  for (int q = 0; q < 16; ++q) {
    const float br = bre[q], bi = bim[q];
    bb[q] = fre * br - fim * bi; bb[16 + q] = fre * bi + fim * br;
    u16* bh = (u16*)(p.ws + OFF_BBH) + ((size_t)(ld * 16 + g) * 128 + 2 * (idx & 63)) * 16;
    bh[q] = bf1(fre * br - fim * bi); bh[16 + q] = bf1(fre * bi + fim * br);
  }
}

DI void prep_tables(const P& p, int u) {
  const int i = u * 256 + get_tid();
  const float TWO_PI = 6.283185307179586f;
  char* ws = p.ws;
  if (i < 3072) {
    const int pos = i >> 4, j = i & 15;
    const float inv = powf(10000.f, -(float)j / 16.f);
    const float ang = (float)(pos < 128 ? pos : pos - 128) * inv;
    ((float2*)(ws + OFF_ROPE))[i] = make_float2(cosf(ang), sinf(ang));
    return;
  }
  int r = i - 3072;
  if (r < 32768) {
    const int row = r >> 7, rr = r & 127, ri = row >> 7, k1 = row & 127;
    const float ang = TWO_PI * (float)((k1 * rr) & 127) / 128.f;
    ((u16*)(ws + OFF_D128))[r] = bf1(ri == 0 ? cosf(ang) : -sinf(ang));
    return;
  }
  r -= 32768;
  if (r < 16384) {
    const int row = r >> 7, kx = r & 127, ri = row >> 6, k2 = row & 63, xri = kx >> 6, col = kx & 63;
    const float ang = TWO_PI * (float)((k2 * col) & 63) / 64.f;
    const float cr = cosf(ang), sr = sinf(ang);
    const float v = ri == 0 ? (xri == 0 ? cr : sr) : (xri == 0 ? -sr : cr);
    ((u16*)(ws + OFF_D64))[r] = bf1(v);
    return;
  }
  r -= 16384;
  if (r < 8192) {
    const int k1 = r >> 6, col = r & 63;
    const float ang = TWO_PI * (float)(k1 * col) / 8192.f;
    ((float2*)(ws + OFF_TW))[r] = make_float2(cosf(ang), -sinf(ang));
    return;
  }
  r -= 8192;
  if (r < DEPTH) {
    const int l = r;
    float s1 = 0.f, s2 = 0.f, gq = 0.f, gk = 0.f;
    for (int q = 0; q < 64; ++q) {
      s1 += p.lam_q1[l * 64 + q] * p.lam_k1[l * 64 + q]; s2 += p.lam_q2[l * 64 + q] * p.lam_k2[l * 64 + q];
      gq = fmaxf(gq, fabsf(p.g_qnorm[l * 64 + q])); gk = fmaxf(gk, fabsf(p.g_knorm[l * 64 + q]));
    }
    float* sm = (float*)(ws + OFF_SMALL);
    sm[l] = expf(s1) - expf(s2) + lam_init_of(l);
    sm[4 + l] = 8.f * gq * gk * LOG2E;
  }
}
constexpr int N_TABLE_UNITS = (3072 + 32768 + 16384 + 8192 + DEPTH + 255) / 256;

DI void prep_wcs(const P& p, int u) {
  const int idx = u * 256 + get_tid();
  const int k = idx & 127, d = (idx >> 7) & 63, lg = idx >> 13;
  const int ri = k >> 6, c = k & 63;
  const float* wf = p.w_fnet + (size_t)lg * 4096;
  float s = 0.f;
  for (int cp = 0; cp < 64; ++cp) {
    const float ang = 6.283185307179586f * (float)((c * cp) & 63) / 64.f;
    s += (ri == 0 ? cosf(ang) : sinf(ang)) * wf[cp * 64 + d];
  }
  ((u16*)(p.ws + OFF_WCS))[idx] = bf1(s * (1.f / 724.0773439350247f));
}

DI void prep_cm(const P& p, int u) {
  const int idx = u * 256 + get_tid();
  const int k = idx & 127, row = idx >> 7;
  const float v = k < 64 ? p.ssm_c_re[(size_t)row * 64 + k] : -p.ssm_c_im[(size_t)row * 64 + (k - 64)];
  ((u16*)(p.ws + OFF_CM))[idx] = bf1(v);
}


DI void norm_unit(const P& p, int layer, int which, int u) {
  const int tid = get_tid(), lane = tid & 63;
  const int r = u * 8 + (tid >> 6);
  const int mt = r >> 7;
  const float* xrow = (which == 0 ? xa_rd_tile(p, layer, mt) : (const float*)xb_tile(p, mt)) + (size_t)(r & 127) * 1024 + lane * 4;
  const float* modl = (const float*)(p.ws + OFF_MOD) + ((size_t)layer * 3 + (r < XTOK ? (r >> 13) : 2)) * 6144 + lane * 4;
  const float* sh = modl + (which == 0 ? 0 : 3072);
  const float* sc = modl + (which == 0 ? 1024 : 4096);
  const float* gn = (which == 0 ? p.g_norm1 : p.g_norm2) + layer * 1024 + lane * 4;
  const float4 v0 = *(const float4*)(xrow), v1 = *(const float4*)(xrow + 256), v2 = *(const float4*)(xrow + 512), v3 = *(const float4*)(xrow + 768);
  const float4 w0 = *(const float4*)(xrow + 4096), w1 = *(const float4*)(xrow + 4096 + 256), w2 = *(const float4*)(xrow + 4096 + 512), w3 = *(const float4*)(xrow + 4096 + 768);
  float4 g0 = *(const float4*)(gn), g1 = *(const float4*)(gn + 256), g2 = *(const float4*)(gn + 512), g3 = *(const float4*)(gn + 768);
  const float4 s0 = *(const float4*)(sc), s1 = *(const float4*)(sc + 256), s2 = *(const float4*)(sc + 512), s3 = *(const float4*)(sc + 768);
  const float4 h0 = *(const float4*)(sh), h1 = *(const float4*)(sh + 256), h2 = *(const float4*)(sh + 512), h3 = *(const float4*)(sh + 768);
#define SSQ4(V) (V.x * V.x + V.y * V.y + V.z * V.z + V.w * V.w)
  float ssa = SSQ4(v0) + SSQ4(v1) + SSQ4(v2) + SSQ4(v3), ssb = SSQ4(w0) + SSQ4(w1) + SSQ4(w2) + SSQ4(w3);
#undef SSQ4
#pragma unroll
  for (int o = 1; o < 64; o <<= 1) { ssa += __shfl_xor(ssa, o); ssb += __shfl_xor(ssb, o); }
  const float ra = rsqrtf(ssa * (1.f / 1024.f) + EPS), rb = rsqrtf(ssb * (1.f / 1024.f) + EPS);
  g0.x *= 1.f + s0.x; g0.y *= 1.f + s0.y; g0.z *= 1.f + s0.z; g0.w *= 1.f + s0.w;
  g1.x *= 1.f + s1.x; g1.y *= 1.f + s1.y; g1.z *= 1.f + s1.z; g1.w *= 1.f + s1.w;
  g2.x *= 1.f + s2.x; g2.y *= 1.f + s2.y; g2.z *= 1.f + s2.z; g2.w *= 1.f + s2.w;
  g3.x *= 1.f + s3.x; g3.y *= 1.f + s3.y; g3.z *= 1.f + s3.z; g3.w *= 1.f + s3.w;
  u16* dst = (u16*)(p.ws + OFF_HN) + (size_t)r * 1024 + lane * 4;
#define NORM_ST(V, RS, Gv, Hv, OFS) do { uint2 o; \
    o.x = pk2(V.x * RS * Gv.x + Hv.x, V.y * RS * Gv.y + Hv.y); \
    o.y = pk2(V.z * RS * Gv.z + Hv.z, V.w * RS * Gv.w + Hv.w); \
    *(uint2*)(dst + (OFS)) = o; } while (0)
  NORM_ST(v0, ra, g0, h0, 0); NORM_ST(v1, ra, g1, h1, 256); NORM_ST(v2, ra, g2, h2, 512); NORM_ST(v3, ra, g3, h3, 768);
  NORM_ST(w0, rb, g0, h0, 4096); NORM_ST(w1, rb, g1, h1, 4096 + 256); NORM_ST(w2, rb, g2, h2, 4096 + 512); NORM_ST(w3, rb, g3, h3, 4096 + 768);
#undef NORM_ST
}

enum { EPI_PROJ = 0, EPI_OUT = 1, EPI_FF1 = 2, EPI_FF2 = 3, EPI_GLU = 4 };
constexpr int LDT = 72;

template <int AMODE, int EPI>
DI void gemm_unit(const P& p, int layer, int mt, int nt, int K, const u16* __restrict__ Wt, const void* __restrict__ Asrc, int lda,
                  const float* gn, const float* sc, const float* sh, char* smem, bool dup, int role = 0, char* smem_other = nullptr) {
  const int tid = get_tid(), lane = tid & 63, w = tid >> 6, wr = w >> 1, wc = w & 1, fr = lane & 15, fq = lane >> 4;
  u16* As = (u16*)smem;
  u16* Bs = As + 2 * 128 * LDT;
  float* rs = (float*)(Bs + 2 * 128 * LDT);
  const int rmod = mt < 128 ? (mt >> 6) : 2;
  const float* modl = (const float*)(p.ws + OFF_MOD) + ((size_t)layer * 3 + rmod) * 6144;
  __syncthreads();
  f32x4 acc[4][4];
#pragma unroll
  for (int m = 0; m < 4; ++m)
#pragma unroll
    for (int n = 0; n < 4; ++n) acc[m][n] = (f32x4){0.f, 0.f, 0.f, 0.f};

  uint4 p0, p1, p2, p3, q0, q1, q2, q3;
  uint4 r0, r1, r2, r3, t0, t1, t2, t3;
  uint4 x0, x1, x2, x3, z0, z1, z2, z3;
  const int nk = role ? K / 128 : K / 64;
  const int kofs = role == 2 ? K / 2 : 0;
  const u16* Ag = (const u16*)Asrc + (size_t)(mt * 128 + (tid >> 3)) * lda + (tid & 7) * 8 + kofs;
  const u16* Bg = Wt + (size_t)(nt * 128 + (tid >> 3)) * K + (tid & 7) * 8 + kofs;
  const int lrow = ((tid >> 3)) * LDT + (tid & 7) * 8;
#define GLOAD(A0, A1, A2, A3, B0, B1, B2, B3, kt)                                                 \
  do {                                                                                            \
    B0 = *(const uint4*)(Bg + (kt) * 64); B1 = *(const uint4*)(Bg + (size_t)32 * K + (kt) * 64);  \
    B2 = *(const uint4*)(Bg + (size_t)64 * K + (kt) * 64); B3 = *(const uint4*)(Bg + (size_t)96 * K + (kt) * 64); \
    A0 = *(const uint4*)(Ag + (kt) * 64); A1 = *(const uint4*)(Ag + (size_t)32 * lda + (kt) * 64); \
    A2 = *(const uint4*)(Ag + (size_t)64 * lda + (kt) * 64); A3 = *(const uint4*)(Ag + (size_t)96 * lda + (kt) * 64); \
  } while (0)
#define LSTORE(A0, A1, A2, A3, B0, B1, B2, B3, buf)                                               \
  do {                                                                                            \
    u16* bs_ = Bs + (buf) * 128 * LDT + lrow; u16* as_ = As + (buf) * 128 * LDT + lrow;          \
    *(uint4*)(bs_) = B0; *(uint4*)(bs_ + 32 * LDT) = B1; *(uint4*)(bs_ + 64 * LDT) = B2; *(uint4*)(bs_ + 96 * LDT) = B3; \
    *(uint4*)(as_) = A0; *(uint4*)(as_ + 32 * LDT) = A1; *(uint4*)(as_ + 64 * LDT) = A2; *(uint4*)(as_ + 96 * LDT) = A3; \
  } while (0)
#define ST0 p0, p1, p2, p3, q0, q1, q2, q3
#define ST1 r0, r1, r2, r3, t0, t1, t2, t3
#define ST2 x0, x1, x2, x3, z0, z1, z2, z3
#define GLOAD_(...) GLOAD(__VA_ARGS__)
#define LSTORE_(...) LSTORE(__VA_ARGS__)
#define COMPUTE(buf)                                                                              \
  do {                                                                                            \
    _Pragma("unroll") for (int kk = 0; kk < 2; ++kk) {                                            \
      bf16x8 af[4], wf[4];                                                                        \
      _Pragma("unroll") for (int m = 0; m < 4; ++m) af[m] = *(const bf16x8*)(As + (buf) * 128 * LDT + (wr * 64 + m * 16 + fr) * LDT + kk * 32 + fq * 8); \
      _Pragma("unroll") for (int n = 0; n < 4; ++n) wf[n] = *(const bf16x8*)(Bs + (buf) * 128 * LDT + (wc * 64 + n * 16 + fr) * LDT + kk * 32 + fq * 8); \
      _Pragma("unroll") for (int m = 0; m < 4; ++m)                                               \
        _Pragma("unroll") for (int n = 0; n < 4; ++n) acc[m][n] = mfma16(wf[n], af[m], acc[m][n]); \
    }                                                                                             \
  } while (0)

#define STEP(SL, SS, buf, i)                                          \
  if (kt + (i) < nk) {                                                \
    if (kt + (i) + 3 < nk) GLOAD_(SL, kt + (i) + 3);                  \
    COMPUTE(buf);                                                     \
    if (kt + (i) + 1 < nk) LSTORE_(SS, (buf) ^ 1);                    \
    __syncthreads();                                                  \
  }
  GLOAD_(ST0, 0);
  GLOAD_(ST1, 1);
  if (nk > 2) GLOAD_(ST2, 2);
  LSTORE_(ST0, 0);
  __syncthreads();
  for (int kt = 0; kt < nk; kt += 6) {
    STEP(ST0, ST1, 0, 0)
    STEP(ST1, ST2, 1, 1)
    STEP(ST2, ST0, 0, 2)
    STEP(ST0, ST1, 1, 3)
    STEP(ST1, ST2, 0, 4)
    STEP(ST2, ST0, 1, 5)
  }
#undef STEP
#undef GLOAD
#undef LSTORE
#undef COMPUTE
#undef ST0
#undef ST1
#undef ST2
#undef GLOAD_
#undef LSTORE_
  if (role) {
    if (role == 2) {
#pragma unroll
      for (int m = 0; m < 4; ++m)
#pragma unroll
        for (int n = 0; n < 4; ++n) *(f32x4*)(smem + ((size_t)((m * 4 + n) * 256 + tid)) * 16) = acc[m][n];
    }
    __syncthreads();
    if (role == 2) return;
#pragma unroll
    for (int m = 0; m < 4; ++m)
#pragma unroll
      for (int n = 0; n < 4; ++n) acc[m][n] = acc[m][n] + *(const f32x4*)(smem_other + ((size_t)((m * 4 + n) * 256 + tid)) * 16);
  }

  if (dup) return;
  const int tok0 = mt * 128 + wr * 64 + fr;
  const int f0 = nt * 128 + wc * 64 + fq * 4;
  char* ws = p.ws;
  if (EPI == EPI_PROJ) {
    const bool isctx = mt >= 128;
    if (nt < 8) {
      const int grp = nt * 2 + wc; const bool isK = grp >= 8; const int gi = grp & 7, hh = gi >> 1, mp = gi & 1;
      const float* gw = (isK ? p.g_knorm : p.g_qnorm) + layer * 64;
      float gwv[4][4];
#pragma unroll
      for (int n = 0; n < 4; ++n) { const float4 t = *(const float4*)(gw + n * 16 + fq * 4); gwv[n][0] = t.x; gwv[n][1] = t.y; gwv[n][2] = t.z; gwv[n][3] = t.w; }
      const float2* rope = (const float2*)(ws + OFF_ROPE);
      const float osc = isK ? 1.f : 0.125f * LOG2E;
#pragma unroll
      for (int m = 0; m < 4; ++m) {
        const int tok = tok0 + m * 16;
        float ss = 0.f;
#pragma unroll
        for (int n = 0; n < 4; ++n)
#pragma unroll
          for (int j = 0; j < 4; ++j) ss += acc[m][n][j] * acc[m][n][j];
        ss += __shfl_xor(ss, 16); ss += __shfl_xor(ss, 32);
        const float rstd = rsqrtf(ss * (1.f / 64.f) + EPS);
        float v[4][4];
#pragma unroll
        for (int n = 0; n < 4; ++n)
#pragma unroll
          for (int j = 0; j < 4; ++j) v[n][j] = acc[m][n][j] * rstd * gwv[n][j];
        u16* dst;
        if (!isctx) {
          const int b = tok >> 13, t = tok & 8191, prow = t >> 6, pcol = t & 63;
#pragma unroll
          for (int n = 0; n < 2; ++n) {
            const float2* rp = rope + (size_t)(n == 0 ? prow : 128 + pcol) * 16 + fq * 4;
#pragma unroll
            for (int j = 0; j < 4; ++j) {
              const float2 cs = rp[j];
              const float x1 = v[n][j], x2 = v[n + 2][j];
              v[n][j] = x1 * cs.x - x2 * cs.y; v[n + 2][j] = x2 * cs.x + x1 * cs.y;
            }
          }
          if (isK) dst = (u16*)(ws + OFF_K) + ((size_t)((b * 4 + hh) * 2 + mp) * LK + 256 + t) * 64;
          else dst = (u16*)(ws + OFF_Q) + ((size_t)((b * 4 + hh) * 2 + mp) * 8192 + t) * 64;
        } else {
          const int tc = tok - XTOK, b = tc >> 8, t = tc & 255;
          if (isK) dst = (u16*)(ws + OFF_K) + ((size_t)((b * 4 + hh) * 2 + mp) * LK + t) * 64;
          else dst = (u16*)(ws + OFF_QC) + ((size_t)((b * 4 + hh) * 2 + mp) * 256 + t) * 64;
        }
#pragma unroll
        for (int n = 0; n < 4; ++n) {
          uint2 o; o.x = pk2(v[n][0] * osc, v[n][1] * osc); o.y = pk2(v[n][2] * osc, v[n][3] * osc);
          *(uint2*)(dst + n * 16 + fq * 4) = o;
        }
      }
    } else if (nt < 12) {
      const int hh = nt - 8;
      u16* vt = (u16*)(ws + OFF_VT);
#pragma unroll
      for (int m = 0; m < 4; ++m) {
        const int tok = tok0 + m * 16;
        int b, key;
        if (!isctx) { b = tok >> 13; key = 256 + (tok & 8191); } else { const int tc = tok - XTOK; b = tc >> 8; key = tc & 255; }
        const size_t base = ((size_t)(b * 4 + hh) * NKT + (key >> 5)) * 128 * 32 + (key & 31);
#pragma unroll
        for (int n = 0; n < 4; ++n)
#pragma unroll
          for (int j = 0; j < 4; ++j) { const int dv = wc * 64 + n * 16 + fq * 4 + j; vt[base + (size_t)dv * 32] = bf1(acc[m][n][j]); }
      }
    } else {
      float* dstb = (float*)(ws + (nt < 14 ? OFF_U : OFF_F));
      const int c0 = (nt & 1) * 128 + wc * 64 + fq * 4;
#pragma unroll
      for (int m = 0; m < 4; ++m) {
        const int tok = tok0 + m * 16;
#pragma unroll
        for (int n = 0; n < 4; ++n) *(f32x4*)(dstb + (size_t)tok * 256 + c0 + n * 16) = acc[m][n];
      }
    }
  } else if (EPI == EPI_OUT || EPI == EPI_FF2) {
    const float* gate = modl + (EPI == EPI_OUT ? 2048 : 5120);
    const bool last = (EPI == EPI_FF2) && (layer == DEPTH - 1);
    const float* xin = (EPI == EPI_OUT) ? xa_rd_tile(p, layer, mt) : (const float*)xb_tile(p, mt);
    float* xout = (EPI == EPI_OUT || last) ? xb_tile(p, mt) : xa_tile(p, mt);
#pragma unroll
    for (int m = 0; m < 4; ++m) {
      const int lrow = wr * 64 + m * 16 + fr;
#pragma unroll
      for (int n = 0; n < 4; ++n) {
        const int f = f0 + n * 16;
        const f32x4 gv = *(const f32x4*)(gate + f);
        f32x4 xv = *(const f32x4*)(xin + (size_t)lrow * 1024 + f);
        xv = xv + gv * acc[m][n];
        *(f32x4*)(xout + (size_t)lrow * 1024 + f) = xv;
      }
    }
  } else if (EPI == EPI_FF1) {
    u16* hid = (u16*)(ws + OFF_HID);
#pragma unroll
    for (int m = 0; m < 4; ++m) {
      const int tok = tok0 + m * 16;
#pragma unroll
      for (int n = 0; n < 4; ++n) {
        f32x4 a = acc[m][n];
#pragma unroll
        for (int j = 0; j < 4; ++j) { const float r = fmaxf(a[j], 0.f); a[j] = r * r; }
        uint2 o; o.x = pk2(a[0], a[1]); o.y = pk2(a[2], a[3]);
        *(uint2*)(hid + (size_t)tok * DFF + f0 + n * 16) = o;
      }
    }
  } else if (EPI == EPI_GLU) {
    const u16* hg = (const u16*)(ws + OFF_HGLU);
    u16* mix = (u16*)(ws + OFF_MIX);
    const float* bg = p.b_glu + layer * 256;
#pragma unroll
    for (int m = 0; m < 4; ++m) {
      const int tok = tok0 + m * 16;
#pragma unroll
      for (int n = 0; n < 4; ++n) {
        const int f = f0 + n * 16;
        const uint2 hv = *(const uint2*)(hg + (size_t)tok * 256 + f);
        const f32x4 bv = *(const f32x4*)(bg + f);
        float h[4] = {bf2f((u16)(hv.x & 0xffff)), bf2f((u16)(hv.x >> 16)), bf2f((u16)(hv.y & 0xffff)), bf2f((u16)(hv.y >> 16))};
        float o[4];
#pragma unroll
        for (int j = 0; j < 4; ++j) { const float z = acc[m][n][j] + bv[j]; o[j] = h[j] / (1.f + __expf(-z)); }
        uint2 ov; ov.x = pk2(o[0], o[1]); ov.y = pk2(o[2], o[3]);
        *(uint2*)(mix + (size_t)tok * 1024 + 512 + f) = ov;
      }
    }
  }
}

DI void attn_unit(const P& p, int layer, int u, char* smem) {
  const int tid = get_tid(), lane = tid & 63, w = tid >> 6, l32 = lane & 31, hf = lane >> 5;
  char* ws = p.ws;
  int b, hh, qb, nkt, lq; const u16* Qsrc; int tokbase;
  if (u < 512) { b = u >> 8; hh = (u >> 6) & 3; qb = u & 63; nkt = NKT; lq = 8192; Qsrc = (const u16*)(ws + OFF_Q); tokbase = b * 8192 + qb * 128; }
  else { const int uu = u - 512; b = uu >> 3; hh = (uu >> 1) & 3; qb = uu & 1; nkt = 8; lq = 256; Qsrc = (const u16*)(ws + OFF_QC); tokbase = XTOK + b * 256 + qb * 128; }
  const u16* Q0 = Qsrc + ((size_t)((b * 4 + hh) * 2) * lq + qb * 128) * 64;
  const u16* K0 = (const u16*)(ws + OFF_K) + (size_t)((b * 4 + hh) * 2) * LK * 64;
  const u16* V0 = (const u16*)(ws + OFF_VT) + (size_t)(b * 4 + hh) * NKT * 4096;
  u16* Qs = (u16*)smem;
  u16* KV = Qs + 2 * 128 * LDT;
  constexpr int KVSTRIDE = 2 * 32 * LDT + 128 * 40;
  const float lam = ((const float*)(ws + OFF_SMALL))[layer];
  __syncthreads();
#pragma unroll
  for (int i = 0; i < 8; ++i) {
    const int pi = tid + 256 * i;
    const int mp = pi >> 10, row = (pi >> 3) & 127, seg = pi & 7;
    *(uint4*)(Qs + (mp * 128 + row) * LDT + seg * 8) = *(const uint4*)(Q0 + (size_t)mp * lq * 64 + row * 64 + seg * 8);
  }
  uint4 kr0, kr1, vr0, vr1;
#define AGLOAD(kt)                                                                         \
  do {                                                                                     \
    kr0 = *(const uint4*)(K0 + (size_t)(kt) * 2048 + tid * 8);                             \
    kr1 = *(const uint4*)(K0 + (size_t)LK * 64 + (size_t)(kt) * 2048 + tid * 8);           \
    vr0 = *(const uint4*)(V0 + (size_t)(kt) * 4096 + tid * 8);                             \
    vr1 = *(const uint4*)(V0 + (size_t)(kt) * 4096 + 2048 + tid * 8);                      \
  } while (0)
#define ALSTORE(buf)                                                                       \
  do {                                                                                     \
    u16* kb = KV + (buf) * KVSTRIDE;                                                       \
    *(uint4*)(kb + (tid >> 3) * LDT + (tid & 7) * 8) = kr0;                                \
    *(uint4*)(kb + 32 * LDT + (tid >> 3) * LDT + (tid & 7) * 8) = kr1;                     \
    u16* vb = kb + 2 * 32 * LDT;                                                           \
    *(uint4*)(vb + (tid >> 2) * 40 + (tid & 3) * 8) = vr0;                                 \
    *(uint4*)(vb + (64 + (tid >> 2)) * 40 + (tid & 3) * 8) = vr1;                          \
  } while (0)
  AGLOAD(0);
  ALSTORE(0);
  __syncthreads();

  f32x16 o1[4], o2[4];
#pragma unroll
  for (int i = 0; i < 4; ++i)
#pragma unroll
    for (int j = 0; j < 16; ++j) { o1[i][j] = 0.f; o2[i][j] = 0.f; }
  float l1 = 0.f, l2 = 0.f;
  const u16* qrow = Qs + (w * 32 + l32) * LDT + hf * 8;

  const bf16x8 qa0 = *(const bf16x8*)(qrow), qa1 = *(const bf16x8*)(qrow + 16);
  for (int kt = 0; kt < nkt; ++kt) {
    const int buf = kt & 1;
    if (kt + 1 < nkt) AGLOAD(kt + 1);
    const u16* kb = KV + buf * KVSTRIDE;
    const u16* vb = kb + 2 * 32 * LDT;
    f32x16 s1, s2;
#pragma unroll
    for (int j = 0; j < 16; ++j) { s1[j] = 0.f; s2[j] = 0.f; }
#pragma unroll
    for (int kk = 0; kk < 4; ++kk) {
      const bf16x8 kf1 = *(const bf16x8*)(kb + l32 * LDT + kk * 16 + hf * 8);
      s1 = mfma32(kf1, kk == 0 ? qa0 : (kk == 1 ? qa1 : *(const bf16x8*)(qrow + kk * 16)), s1);
      const bf16x8 kf2 = *(const bf16x8*)(kb + 32 * LDT + l32 * LDT + kk * 16 + hf * 8);
      const bf16x8 qf2 = *(const bf16x8*)(qrow + 128 * LDT + kk * 16);
      s2 = mfma32(kf2, qf2, s2);
    }
    bf16x8 pf1[2], pf2[2];
    {
      unsigned pk[8], pq[8];
#pragma unroll
      for (int j = 0; j < 8; ++j) {
        const float a0 = __builtin_amdgcn_exp2f(s1[2 * j]), a1 = __builtin_amdgcn_exp2f(s1[2 * j + 1]);
        const float c0 = __builtin_amdgcn_exp2f(s2[2 * j]), c1 = __builtin_amdgcn_exp2f(s2[2 * j + 1]);
        l1 += a0 + a1; l2 += c0 + c1;
        pk[j] = pk2(a0, a1); pq[j] = pk2(c0, c1);
      }
      typedef unsigned u32x4 __attribute__((ext_vector_type(4)));
      pf1[0] = __builtin_bit_cast(bf16x8, (u32x4){pk[0], pk[1], pk[2], pk[3]});
      pf1[1] = __builtin_bit_cast(bf16x8, (u32x4){pk[4], pk[5], pk[6], pk[7]});
      pf2[0] = __builtin_bit_cast(bf16x8, (u32x4){pq[0], pq[1], pq[2], pq[3]});
      pf2[1] = __builtin_bit_cast(bf16x8, (u32x4){pq[4], pq[5], pq[6], pq[7]});
    }
#pragma unroll
    for (int blk = 0; blk < 4; ++blk) {
#pragma unroll
      for (int s = 0; s < 2; ++s) {
        const u16* vp = vb + (blk * 32 + l32) * 40 + 16 * s + 4 * hf;
        const uint2 lo = *(const uint2*)vp, hi = *(const uint2*)(vp + 8);
        typedef unsigned u32x4 __attribute__((ext_vector_type(4)));
        const bf16x8 vf = __builtin_bit_cast(bf16x8, (u32x4){lo.x, lo.y, hi.x, hi.y});
        o1[blk] = mfma32(vf, pf1[s], o1[blk]);
        o2[blk] = mfma32(vf, pf2[s], o2[blk]);
      }
    }
    if (kt + 1 < nkt) ALSTORE(buf ^ 1);
    __syncthreads();
  }
#undef AGLOAD
#undef ALSTORE
  l1 += __shfl_xor(l1, 32); l2 += __shfl_xor(l2, 32);
  const float i1 = 1.f / l1, i2 = lam / l2;
  float ss = 0.f;
#pragma unroll
  for (int blk = 0; blk < 4; ++blk)
#pragma unroll
    for (int j = 0; j < 16; ++j) { const float v = o1[blk][j] * i1 - o2[blk][j] * i2; o1[blk][j] = v; ss += v * v; }
  ss += __shfl_xor(ss, 32);
  const float rstd = rsqrtf(ss * (1.f / 128.f) + EPS) * (1.f - lam_init_of(layer));
  const float* gs = p.g_subln + layer * 128;
  u16* mix = (u16*)(ws + OFF_MIX) + (size_t)(tokbase + w * 32 + l32) * 1024 + hh * 128;
#pragma unroll
  for (int blk = 0; blk < 4; ++blk)
#pragma unroll
    for (int g4 = 0; g4 < 4; ++g4) {
      const int dv = blk * 32 + 8 * g4 + 4 * hf;
      const float4 gv = *(const float4*)(gs + dv);
      uint2 o;
      o.x = pk2(o1[blk][4 * g4] * rstd * gv.x, o1[blk][4 * g4 + 1] * rstd * gv.y);
      o.y = pk2(o1[blk][4 * g4 + 2] * rstd * gv.z, o1[blk][4 * g4 + 3] * rstd * gv.w);
      *(uint2*)(mix + dv) = o;
    }
}

template <bool FINAL, bool HORNER>
DI void ssm_unit(const P& p, int layer, int b, int blk, char* smem) {
  const int tid = get_tid(), lane = tid & 63, w = tid >> 6, fr = lane & 15, fq = lane >> 4;
  char* ws = p.ws;
  int tok0, cf, cr;
  if (blk < 256) { tok0 = b * 8192 + blk * 32; cf = 8 + blk; cr = 8 + 255 - blk; }
  else { const int cb = blk - 256; tok0 = XTOK + b * 256 + cb * 32; cf = cb; cr = 7 - cb; }
  u16* ub = (u16*)smem;
  float* BUw = (float*)(smem + 16896) + w * 16 * 132;
  __syncthreads();
  {
    const float4* src = (const float4*)((const float*)(ws + OFF_U) + (size_t)tok0 * 256);
#pragma unroll
    for (int i = 0; i < 8; ++i) {
      const int e = tid + 256 * i, row = e >> 6, c4 = (e & 63) * 4;
      const float4 v = src[e];
      uint2 o; o.x = pk2(v.x, v.y); o.y = pk2(v.z, v.w);
      *(uint2*)(ub + row * 264 + c4) = o;
    }
  }
  __syncthreads();
  const float2* AB = (const float2*)(ws + OFF_AB);
  const u16* BBH = (const u16*)(ws + OFF_BBH);
  const u16* CM = (const u16*)(ws + OFF_CM);
  float2* LOC = (float2*)(ws + OFF_LOCAL);
  const float2* CAR = (const float2*)(ws + OFF_CARRY);
  const bf16x8 zero8 = {0, 0, 0, 0, 0, 0, 0, 0};
  for (int gi = 0; gi < 4; ++gi) {
    const int g = w * 4 + gi;
    f32x4 y0 = (f32x4){0.f, 0.f, 0.f, 0.f}, y1 = (f32x4){0.f, 0.f, 0.f, 0.f};
#pragma unroll
    for (int dir = 0; dir < 2; ++dir) {
      const int sidx = ((layer * 2 + dir) * 16 + g) * 64 + lane;
      const float2 a = AB[sidx];
      const int chunk = dir ? cr : cf;
      const size_t cidx = ((size_t)((b * 2 + dir) * NCH + chunk) * 16 + g) * 64 + lane;
      float sr, si;
      if (FINAL && !HORNER) { const float2 c0 = CAR[cidx]; sr = c0.x; si = c0.y; }
      else { opaque_zero2(sr, si); }
      if (FINAL && HORNER) {
        const float2 aT = ((const float2*)(ws + OFF_AT))[sidx];
        const float2* lp = LOC + ((size_t)((b * 2 + dir) * NCH) * 16 + g) * 64 + lane;
        for (int c = 0; c < chunk; ++c) {
          const float2 lo = lp[(size_t)c * 1024];
          const float nr = aT.x * sr - aT.y * si + lo.x, ni = aT.x * si + aT.y * sr + lo.y;
          sr = nr; si = ni;
        }
      }
      const u16* bbp = BBH + ((size_t)((layer * 2 + dir) * 16 + g) * 128 + fr) * 16 + (fq & 1) * 8;
      const u16* cmp = CM + ((size_t)((layer * 2 + dir) * 16 + g) * 16 + fr) * 128 + fq * 8;
      bf16x8 bfr0 = *(const bf16x8*)(bbp), bfr1 = *(const bf16x8*)(bbp + 256), bfr2 = *(const bf16x8*)(bbp + 512), bfr3 = *(const bf16x8*)(bbp + 768);
      bf16x8 bfr4 = *(const bf16x8*)(bbp + 1024), bfr5 = *(const bf16x8*)(bbp + 1280), bfr6 = *(const bf16x8*)(bbp + 1536), bfr7 = *(const bf16x8*)(bbp + 1792);
      if (fq >= 2) { bfr0 = zero8; bfr1 = zero8; bfr2 = zero8; bfr3 = zero8; bfr4 = zero8; bfr5 = zero8; bfr6 = zero8; bfr7 = zero8; }
      bf16x8 cf0 = zero8, cf1 = zero8, cf2 = zero8, cf3 = zero8;
      if (FINAL) { cf0 = *(const bf16x8*)(cmp); cf1 = *(const bf16x8*)(cmp + 32); cf2 = *(const bf16x8*)(cmp + 64); cf3 = *(const bf16x8*)(cmp + 96); }
#pragma unroll
      for (int hh = 0; hh < 2; ++hh) {
        const int tb = dir ? 1 - hh : hh;
        {
          const bf16x8 ufl = *(const bf16x8*)(ub + (tb * 16 + fr) * 264 + g * 16 + (fq & 1) * 8);
          const bf16x8 uf = fq < 2 ? ufl : zero8;
#define BU_(CBI, BF) do { const f32x4 d = mfma16(BF, uf, (f32x4){0.f, 0.f, 0.f, 0.f}); *(f32x4*)(BUw + fr * 132 + (CBI) * 16 + fq * 4) = d; } while (0)
          BU_(0, bfr0); BU_(1, bfr1); BU_(2, bfr2); BU_(3, bfr3); BU_(4, bfr4); BU_(5, bfr5); BU_(6, bfr6); BU_(7, bfr7);
#undef BU_
        }
        __syncthreads();
#pragma unroll 4
        for (int tt = 0; tt < 16; ++tt) {
          const int tl = dir ? 15 - tt : tt;
          const float2 bu = *(const float2*)(BUw + tl * 132 + 2 * lane);
          const float nr = a.x * sr - a.y * si + bu.x, ni = a.x * si + a.y * sr + bu.y;
          sr = nr; si = ni;
          if (FINAL) { u16* srow = (u16*)(BUw + tl * 132); srow[lane] = bf1(sr); srow[64 + lane] = bf1(si); }
        }
        __syncthreads();
        if (FINAL) {
          f32x4 yy = tb == 0 ? y0 : y1;
          const u16* sp = (const u16*)(BUw + fr * 132) + fq * 8;
          yy = mfma16(cf0, *(const bf16x8*)(sp), yy);
          yy = mfma16(cf1, *(const bf16x8*)(sp + 32), yy);
          yy = mfma16(cf2, *(const bf16x8*)(sp + 64), yy);
          yy = mfma16(cf3, *(const bf16x8*)(sp + 96), yy);
          if (tb == 0) y0 = yy; else y1 = yy;
          __syncthreads();
        }
      }
      if (!FINAL) LOC[cidx] = make_float2(sr, si);
    }
    if (FINAL) {
      const int ch = g * 16 + fq * 4;
      const float4 dsk = *(const float4*)(p.ssm_d + layer * 256 + ch);
      u16* hg = (u16*)(ws + OFF_HGLU);
#pragma unroll
      for (int tb = 0; tb < 2; ++tb) {
        const int t = tb * 16 + fr;
        const f32x4 yv = tb == 0 ? y0 : y1;
        const uint2 uraw = *(const uint2*)(ub + t * 264 + ch);
        const float u0 = bf2f((u16)(uraw.x & 0xffff)), u1 = bf2f((u16)(uraw.x >> 16)), u2 = bf2f((u16)(uraw.y & 0xffff)), u3 = bf2f((u16)(uraw.y >> 16));
        const float r0 = gelu_tanh(yv[0] + dsk.x * u0), r1 = gelu_tanh(yv[1] + dsk.y * u1);
        const float r2 = gelu_tanh(yv[2] + dsk.z * u2), r3 = gelu_tanh(yv[3] + dsk.w * u3);
        uint2 o; o.x = pk2(r0, r1); o.y = pk2(r2, r3);
        *(uint2*)(hg + (size_t)(tok0 + t) * 256 + ch) = o;
      }
    }
  }
}

DI void ssm_carry_unit(const P& p, int layer, int u, char* smem) {
  const int tid = get_tid(), seg = tid >> 5, sl = tid & 31;
  const int st = u * 32 + sl;
  const int gn = st & 1023, bd = st >> 10, dir = bd & 1;
  float2* tot = (float2*)smem;
  const float2 aT = ((const float2*)(p.ws + OFF_AT))[((layer * 2 + dir) * 1024) + gn];
  const float2* LOC = (const float2*)(p.ws + OFF_LOCAL) + (size_t)bd * NCH * 1024 + gn + (size_t)seg * 33 * 1024;
  float2* CAR = (float2*)(p.ws + OFF_CARRY) + (size_t)bd * NCH * 1024 + gn + (size_t)seg * 33 * 1024;
  __syncthreads();
  float sr, si;
  opaque_zero2(sr, si);
  float pr = 1.f, pi = 0.f;
#pragma unroll 11
  for (int j = 0; j < 33; ++j) {
    const float2 lo = LOC[(size_t)j * 1024];
    const float nr = aT.x * sr - aT.y * si + lo.x, ni = aT.x * si + aT.y * sr + lo.y;
    sr = nr; si = ni;
    const float qr = pr * aT.x - pi * aT.y, qi = pr * aT.y + pi * aT.x;
    pr = qr; pi = qi;
  }
  tot[seg * 32 + sl] = make_float2(sr, si);
  __syncthreads();
  opaque_zero2(sr, si);
  for (int k = 0; k < seg; ++k) {
    const float2 t = tot[k * 32 + sl];
    const float nr = pr * sr - pi * si + t.x, ni = pr * si + pi * sr + t.y;
    sr = nr; si = ni;
  }
#pragma unroll 11
  for (int j = 0; j < 33; ++j) {
    CAR[(size_t)j * 1024] = make_float2(sr, si);
    const float2 lo = LOC[(size_t)j * 1024];
    const float nr = aT.x * sr - aT.y * si + lo.x, ni = aT.x * si + aT.y * sr + lo.y;
    sr = nr; si = ni;
  }
}

DI void fft1_unit(const P& p, int u, char* smem) {
  const int tid = get_tid(), lane = tid & 63, w = tid >> 6, fr = lane & 15, fq = lane >> 4;
  const int b = u >> 8, col = (u >> 2) & 63, g = u & 3;
  u16* Ht = (u16*)smem;
  __syncthreads();
  const float* F = (const float*)(p.ws + OFF_F);
#pragma unroll
  for (int i = 0; i < 8; ++i) {
    const int r = (tid >> 4) + 16 * i, c4 = (tid & 15) * 4;
    const float4 v = *(const float4*)(F + (size_t)(b * 8192 + 64 * r + col) * 256 + g * 64 + c4);
    Ht[(c4 + 0) * 136 + r] = bf1(v.x); Ht[(c4 + 1) * 136 + r] = bf1(v.y); Ht[(c4 + 2) * 136 + r] = bf1(v.z); Ht[(c4 + 3) * 136 + r] = bf1(v.w);
  }
  __syncthreads();
  f32x4 acc[4][4];
#pragma unroll
  for (int n = 0; n < 4; ++n)
#pragma unroll
    for (int m = 0; m < 4; ++m) acc[n][m] = (f32x4){0.f, 0.f, 0.f, 0.f};
  const u16* D = (const u16*)(p.ws + OFF_D128);
#pragma unroll
  for (int kk = 0; kk < 4; ++kk) {
    bf16x8 hfv[4], df[4];
#pragma unroll
    for (int n = 0; n < 4; ++n) hfv[n] = *(const bf16x8*)(Ht + (n * 16 + fr) * 136 + kk * 32 + fq * 8);
#pragma unroll
    for (int m = 0; m < 4; ++m) df[m] = *(const bf16x8*)(D + (size_t)(64 * w + 16 * m + fr) * 128 + kk * 32 + fq * 8);
#pragma unroll
    for (int n = 0; n < 4; ++n)
#pragma unroll
      for (int m = 0; m < 4; ++m) acc[n][m] = mfma16(hfv[n], df[m], acc[n][m]);
  }
  float* T = (float*)(p.ws + OFF_T);
#pragma unroll
  for (int m = 0; m < 4; ++m) {
    const int dr = 64 * w + 16 * m + fr, ri = dr >> 7, k1 = dr & 127;
    float* dst = T + ((size_t)(((b * 4 + g) * 128 + k1) * 2 + ri) * 64 + col) * 64;
#pragma unroll
    for (int n = 0; n < 4; ++n) *(f32x4*)(dst + n * 16 + fq * 4) = acc[n][m];
  }
}

DI void fft2_unit(const P& p, int layer, int u, char* smem) {
  const int tid = get_tid(), lane = tid & 63, w = tid >> 6, fr = lane & 15, fq = lane >> 4;
  const int b = u >> 9, k1 = (u >> 2) & 127, g = u & 3;
  u16* Xt = (u16*)smem;
  u16* Gt = Xt + 64 * 136;
  __syncthreads();
  const float* T = (const float*)(p.ws + OFF_T) + (size_t)(((b * 4 + g) * 128 + k1) * 2) * 4096;
  const float2* TW = (const float2*)(p.ws + OFF_TW) + k1 * 64;
#pragma unroll
  for (int i = 0; i < 4; ++i) {
    const int col = (tid >> 4) + 16 * i, c4 = (tid & 15) * 4;
    const float4 re = *(const float4*)(T + col * 64 + c4), im = *(const float4*)(T + 4096 + col * 64 + c4);
    const float2 tw = TW[col];
    const float rr[4] = {re.x, re.y, re.z, re.w}, ii[4] = {im.x, im.y, im.z, im.w};
#pragma unroll
    for (int e = 0; e < 4; ++e) {
      Xt[(c4 + e) * 136 + col] = bf1(rr[e] * tw.x - ii[e] * tw.y);
      Xt[(c4 + e) * 136 + 64 + col] = bf1(rr[e] * tw.y + ii[e] * tw.x);
    }
  }
  __syncthreads();
  {
    f32x4 acc[4][2];
#pragma unroll
    for (int n = 0; n < 4; ++n) { acc[n][0] = (f32x4){0.f, 0.f, 0.f, 0.f}; acc[n][1] = (f32x4){0.f, 0.f, 0.f, 0.f}; }
    const u16* D = (const u16*)(p.ws + OFF_D64);
#pragma unroll
    for (int kk = 0; kk < 4; ++kk) {
      bf16x8 xf[4], df[2];
#pragma unroll
      for (int n = 0; n < 4; ++n) xf[n] = *(const bf16x8*)(Xt + (n * 16 + fr) * 136 + kk * 32 + fq * 8);
#pragma unroll
      for (int m = 0; m < 2; ++m) df[m] = *(const bf16x8*)(D + (size_t)(32 * w + 16 * m + fr) * 128 + kk * 32 + fq * 8);
#pragma unroll
      for (int n = 0; n < 4; ++n)
#pragma unroll
        for (int m = 0; m < 2; ++m) acc[n][m] = mfma16(xf[n], df[m], acc[n][m]);
    }
#pragma unroll
    for (int m = 0; m < 2; ++m) {
      const int row2 = 32 * w + 16 * m + fr, ri = row2 >> 6, k2 = row2 & 63;
#pragma unroll
      for (int n = 0; n < 4; ++n) {
        uint2 o; o.x = pk2(acc[n][m][0], acc[n][m][1]); o.y = pk2(acc[n][m][2], acc[n][m][3]);
        *(uint2*)(Gt + k2 * 136 + ri * 64 + n * 16 + fq * 4) = o;
      }
    }
  }
  __syncthreads();
  {
    f32x4 acc[4];
#pragma unroll
    for (int n = 0; n < 4; ++n) acc[n] = (f32x4){0.f, 0.f, 0.f, 0.f};
    const u16* W = (const u16*)(p.ws + OFF_WCS) + (size_t)(layer * 4 + g) * 64 * 128;
#pragma unroll
    for (int kk = 0; kk < 4; ++kk) {
      const bf16x8 gf = *(const bf16x8*)(Gt + (16 * w + fr) * 136 + kk * 32 + fq * 8);
#pragma unroll
      for (int n = 0; n < 4; ++n) {
        const bf16x8 wf = *(const bf16x8*)(W + (size_t)(n * 16 + fr) * 128 + kk * 32 + fq * 8);
        acc[n] = mfma16(wf, gf, acc[n]);
      }
    }
    const int k2 = 16 * w + fr;
    u16* mix = (u16*)(p.ws + OFF_MIX) + (size_t)(b * 8192 + k1 + 128 * k2) * 1024 + 768 + g * 64;
#pragma unroll
    for (int n = 0; n < 4; ++n) {
      uint2 o; o.x = pk2(acc[n][0], acc[n][1]); o.y = pk2(acc[n][2], acc[n][3]);
      *(uint2*)(mix + n * 16 + fq * 4) = o;
    }
  }
}

DI void ctxfft_unit(const P& p, int layer, int u, char* smem) {
  const int tid = get_tid();
  const int b = u >> 6, g = (u >> 4) & 3, kb = u & 15;
  float2* tab = (float2*)smem;
  float* Gs = (float*)(smem + 2048);
  float* zs = Gs + 16 * 128;
  __syncthreads();
  { const float ang = 6.283185307179586f * (float)tid / 256.f; tab[tid] = make_float2(cosf(ang), sinf(ang)); }
  __syncthreads();
  const int kl = tid >> 4, c4 = (tid & 15) * 4, k = kb * 16 + kl;
  const float* F = (const float*)(p.ws + OFF_F) + (size_t)(XTOK + b * 256) * 256 + g * 64 + c4;
  float gr[4] = {0.f, 0.f, 0.f, 0.f}, gim[4] = {0.f, 0.f, 0.f, 0.f};
#pragma unroll 16
  for (int l = 0; l < 256; ++l) {
    const float4 hv = *(const float4*)(F + (size_t)l * 256);
    const float2 cs = tab[(k * l) & 255];
    gr[0] += cs.x * hv.x; gr[1] += cs.x * hv.y; gr[2] += cs.x * hv.z; gr[3] += cs.x * hv.w;
    gim[0] -= cs.y * hv.x; gim[1] -= cs.y * hv.y; gim[2] -= cs.y * hv.z; gim[3] -= cs.y * hv.w;
  }
#pragma unroll
  for (int e = 0; e < 4; ++e) { Gs[kl * 128 + c4 + e] = gr[e]; Gs[kl * 128 + 64 + c4 + e] = gim[e]; }
  __syncthreads();
  float z[4] = {0.f, 0.f, 0.f, 0.f};
  for (int c = 0; c < 64; ++c) {
    const float a = Gs[kl * 128 + c], bi = Gs[kl * 128 + 64 + c];
#pragma unroll
    for (int e = 0; e < 4; ++e) { const float2 cs = tab[((c * (c4 + e)) & 63) * 4]; z[e] += a * cs.x + bi * cs.y; }
  }
#pragma unroll
  for (int e = 0; e < 4; ++e) zs[kl * 64 + c4 + e] = z[e] * (1.f / 128.f);
  __syncthreads();
  const float* wf = p.w_fnet + (size_t)(layer * 4 + g) * 4096;
  float o[4] = {0.f, 0.f, 0.f, 0.f};
  for (int cp = 0; cp < 64; ++cp) {
    const float zv = zs[kl * 64 + cp];
    const float4 wv = *(const float4*)(wf + cp * 64 + c4);
    o[0] += zv * wv.x; o[1] += zv * wv.y; o[2] += zv * wv.z; o[3] += zv * wv.w;
  }
  u16* mix = (u16*)(p.ws + OFF_MIX) + (size_t)(XTOK + b * 256 + k) * 1024 + 768 + g * 64 + c4;
  uint2 ov; ov.x = pk2(o[0], o[1]); ov.y = pk2(o[2], o[3]);
  *(uint2*)mix = ov;
}


#define XB_TMO      128
#define XB_XCNT(j)  (256  + 64 * (j))
#define XB_XSUB(j)  (1280 + 64 * (j))
#define XB_XGEN(j)  (2304 + 64 * (j))
#define XB_TOP      3328
#define XB_TOPGEN   3392
#define XB_SPIN_CAP (1u << 18)
#define LAS __attribute__((address_space(3)))
DI unsigned xb_ld(unsigned* q) { return __hip_atomic_load(q, __ATOMIC_RELAXED, __HIP_MEMORY_SCOPE_AGENT); }
DI unsigned xb_add(unsigned* q, unsigned v) { return __hip_atomic_fetch_add(q, v, __ATOMIC_RELAXED, __HIP_MEMORY_SCOPE_AGENT); }
DI unsigned xb_xcc_id() { return (unsigned)__builtin_amdgcn_s_getreg((3 << 11) | 20) & 0xFu; }
#define XB_SPIN(cond, bar) do { unsigned _sp = 0; while (cond) { __builtin_amdgcn_s_sleep(1); \
    if ((++_sp & 255u) == 0u) { if (xb_ld(&(bar)[XB_TMO])) break; if (_sp > XB_SPIN_CAP) { atomicAdd(&(bar)[XB_TMO], 1u); break; } } } } while (0)
struct XcdBarrier { unsigned* bar; unsigned x; volatile LAS unsigned* st; };
DI XcdBarrier xcd_barrier_post(unsigned* bar, volatile LAS unsigned* st) {
  XcdBarrier b; b.bar = bar; b.x = xb_xcc_id(); b.st = st;
  if (threadIdx.x == 0) (void)xb_add(&bar[XB_XCNT(b.x)], 1u);
  return b;
}
DI void xcd_barrier_complete(unsigned* bar, unsigned x, unsigned& nloc, unsigned& nx) {
  const unsigned G = gridDim.x * gridDim.y * gridDim.z;
  unsigned sum, cnt, mine, sp = 0u;
  for (;;) {
    sum = 0u; cnt = 0u; mine = 0u;
#pragma unroll
    for (unsigned j = 0; j < 16; ++j) { const unsigned c = xb_ld(&bar[XB_XCNT(j)]); sum += c; cnt += (c > 0u) ? 1u : 0u; mine = (j == x) ? c : mine; }
    if (sum == G) break;
    __builtin_amdgcn_s_sleep(1);
    if ((++sp & 255u) == 0u) { if (xb_ld(&bar[XB_TMO])) break; if (sp > XB_SPIN_CAP) { atomicAdd(&bar[XB_TMO], 1u); break; } }
  }
  nloc = mine > 0u ? mine : 1u; nx = cnt > 0u ? cnt : 1u;
}
DI void xcd_barrier(const XcdBarrier& b) {
  asm volatile("s_waitcnt vmcnt(0)" ::: "memory");
  __syncthreads();
  if (threadIdx.x == 0) {
    unsigned* bar = b.bar;
    __builtin_amdgcn_s_waitcnt(0);
    unsigned nloc = b.st[0], nx = b.st[1];
    if (nloc == 0u) { xcd_barrier_complete(bar, b.x, nloc, nx); b.st[0] = nloc; b.st[1] = nx; }
    const unsigned old = xb_add(&bar[XB_XSUB(b.x)], 1u);
    const unsigned gen = old / nloc;
    if (old + 1u == (gen + 1u) * nloc) {
      __builtin_amdgcn_fence(__ATOMIC_RELEASE, "agent");
      asm volatile("s_waitcnt vmcnt(0)" ::: "memory");
      const unsigned og = xb_add(&bar[XB_TOP], 1u);
      const unsigned tg = og / nx;
      if (og + 1u == (tg + 1u) * nx) xb_add(&bar[XB_TOPGEN], 1u);
      else XB_SPIN(xb_ld(&bar[XB_TOPGEN]) == tg, bar);
      __builtin_amdgcn_fence(__ATOMIC_ACQUIRE, "agent");
      xb_add(&bar[XB_XGEN(b.x)], 1u);
      asm volatile("s_waitcnt vmcnt(0)" ::: "memory");
    } else {
      XB_SPIN(xb_ld(&bar[XB_XGEN(b.x)]) == gen, bar);
      __builtin_amdgcn_fence(__ATOMIC_ACQUIRE, "agent");
      asm volatile("s_waitcnt vmcnt(0)" ::: "memory");
    }
  }
  __syncthreads();
}

constexpr int NSUB = 10;
constexpr int NPHASE = 1 + DEPTH * NSUB;
DI int sub_of(int i) { return (int)((0x76d54983ba210cULL >> (4 * i)) & 15ULL); }

#define LOOPB(N, ROT, ...) do { const int n_ = (N); int br_ = B - (ROT); if (br_ < 0) br_ += G; \
    for (int u0_ = br_ & ~1; u0_ < n_; u0_ += G) { int u = u0_ + (br_ & 1); const bool dup = u >= n_; if (dup) u = n_ - 1; __VA_ARGS__; } } while (0)
#define LOOPG(N, CALL) do { const int n_ = (N); const int full_ = (n_ / G) * G; const int rem_ = n_ - full_; \
    for (int u = B; u < full_; u += G) { CALL(u, false, 0); } \
    if (rem_ > 0) { \
      if (rem_ * 2 <= G) { const int wg_ = B >> 1; if (wg_ < rem_) { CALL(full_ + wg_, false, (B & 1) + 1); } } \
      else { const int u0_ = full_ + (B & ~1); if (u0_ < n_) { int u = u0_ + (B & 1); const bool dup = u >= n_; if (dup) u = n_ - 1; CALL(u, dup, 0); } } \
    } } while (0)
#define LOOPN(N, ROT, ...) do { const int n_ = (N); int br_ = B - (ROT); if (br_ < 0) br_ += G; \
    for (int u = br_; u < n_; u += G) { __VA_ARGS__; } } while (0)

DI void run_phase(const P& p, int ph, char* smem) {
  const int G = gridDim.x * 2, B = blockIdx.x * 2 + __builtin_amdgcn_readfirstlane(threadIdx.x >> 8);
  char* ws = p.ws;
  char* smem_o = (B & 1) ? smem - LDS_BYTES : smem + LDS_BYTES;
  if (ph == 0) {
    LOOPB(11328, 0, prep_transposes(p, u, smem));
    LOOPB(384, 0, prep_mod(p, u, smem));
    LOOPN(32, 384, prep_disc(p, u));
    LOOPN(N_TABLE_UNITS, 0, prep_tables(p, u));
    LOOPN(512, 0, prep_wcs(p, u));
    LOOPN(1024, 0, prep_cm(p, u));
    return;
  }
  const int layer = (ph - 1) / NSUB, sub = (ph - 1) % NSUB;
  const bool lastl = layer == DEPTH - 1;
  const int nmt = lastl ? 128 : 132;
  switch (sub) {
    case 0: LOOPN(2112, 0, norm_unit(p, layer, 0, u)); break;
    case 1: {
      const u16* Wt = (const u16*)(ws + OFF_WIN) + (size_t)layer * 2048 * 1024;
#define CALL_(u, dup, role) gemm_unit<1, EPI_PROJ>(p, layer, (u) >> 4, (u) & 15, 1024, Wt, ws + OFF_HN, 1024, nullptr, nullptr, nullptr, smem, dup, role, smem_o)
      LOOPG(132 * 16, CALL_);
#undef CALL_
    } break;
    case 2: {
      LOOPB(512, 0, (ssm_unit<false, false>(p, layer, u >> 8, u & 255, smem)));
      LOOPB(16, 0, (ssm_unit<false, false>(p, layer, u >> 3, 256 + (u & 7), smem)));
      LOOPB(512, 0, fft1_unit(p, u, smem));
      if (!lastl) LOOPB(128, 16, ctxfft_unit(p, layer, u, smem));
    } break;
    case 3: {
      LOOPB(128, 0, ssm_carry_unit(p, layer, u, smem));
      if (!lastl) LOOPB(16, 128, (ssm_unit<true, true>(p, layer, u >> 3, 256 + (u & 7), smem)));
      if (!lastl) LOOPB(16, 144, attn_unit(p, layer, 512 + u, smem));
      LOOPB(1024, 0, fft2_unit(p, layer, u, smem));
    } break;
    case 4: {
      LOOPB(512, 0, attn_unit(p, layer, u, smem));
      LOOPB(512, 0, (ssm_unit<true, false>(p, layer, u >> 8, u & 255, smem)));
    } break;
    case 5: {
      const u16* Wt = (const u16*)(ws + OFF_WGLU) + (size_t)layer * 256 * 256;
      LOOPB(nmt * 2, 0, (gemm_unit<1, EPI_GLU>(p, layer, u >> 1, u & 1, 256, Wt, ws + OFF_HGLU, 256, nullptr, nullptr, nullptr, smem, dup)));
    } break;
    case 6: {
      const u16* Wt = (const u16*)(ws + OFF_WOUT) + (size_t)layer * 1024 * 1024;
#define CALL_(u, dup, role) gemm_unit<1, EPI_OUT>(p, layer, (u) >> 3, (u) & 7, 1024, Wt, ws + OFF_MIX, 1024, nullptr, nullptr, nullptr, smem, dup, role, smem_o)
      LOOPG(nmt * 8, CALL_);
#undef CALL_
    } break;
    case 7: LOOPN(nmt * 16, 0, norm_unit(p, layer, 1, u)); break;
    case 8: {
      const u16* Wt = (const u16*)(ws + OFF_WFF1) + (size_t)layer * 4096 * 1024;
#define CALL_(u, dup, role) gemm_unit<1, EPI_FF1>(p, layer, (u) >> 5, (u) & 31, 1024, Wt, ws + OFF_HN, 1024, nullptr, nullptr, nullptr, smem, dup, role, smem_o)
      LOOPG(nmt * 32, CALL_);
#undef CALL_
    } break;
    case 9: {
      const u16* Wt = (const u16*)(ws + OFF_WFF2) + (size_t)layer * 1024 * 4096;
#define CALL_(u, dup, role) gemm_unit<1, EPI_FF2>(p, layer, (u) >> 3, (u) & 7, 4096, Wt, ws + OFF_HID, 4096, nullptr, nullptr, nullptr, smem, dup, role, smem_o)
      LOOPG(nmt * 8, CALL_);
#undef CALL_
    } break;
  }
}

__global__ void __launch_bounds__(512) mega(P p, int ph_lo, int ph_hi, int coop) {
  __shared__ __attribute__((aligned(16))) char smem_all[2 * LDS_BYTES];
  __shared__ uint4 xb_words;
  char* smem = smem_all + __builtin_amdgcn_readfirstlane(threadIdx.x >> 8) * LDS_BYTES;
  if (threadIdx.x == 0) xb_words = make_uint4(0u, 0u, 0u, 0u);
  __syncthreads();
  XcdBarrier xb = xcd_barrier_post((unsigned*)(p.ws + OFF_BAR), (volatile LAS unsigned*)&xb_words);
  for (int ph = ph_lo; ph < ph_hi; ++ph) {
    P q = p;
    asm volatile("" : "+s"(q.ws));
    run_phase(q, ph, smem);
    if (coop && ph + 1 < ph_hi) {
      if (ph == ph_lo) {
        asm volatile("s_waitcnt vmcnt(0)" ::: "memory");
        cg::this_grid().sync();
        if (threadIdx.x < 64) {
          __builtin_amdgcn_fence(__ATOMIC_ACQUIRE, "agent");
          asm volatile("s_waitcnt vmcnt(0)" ::: "memory");
        }
        __syncthreads();
      } else {
        xcd_barrier(xb);
      }
    }
  }
}

#ifdef DBG_DUMP
__global__ void __launch_bounds__(256) dumpk(P p) {
  const size_t n = (size_t)XTOK * 1024;
  for (size_t i = (size_t)blockIdx.x * 256 + threadIdx.x; i < n; i += (size_t)gridDim.x * 256) {
#if DBG_DUMP == 0
    { const int cc = (int)(i & 1023); p.out[i] = (cc >= DBG_CLO && cc < DBG_CHI) ? bf2f(((const u16*)(p.ws + OFF_MIX))[i]) : 0.f; }
#elif DBG_DUMP == 8
    p.out[i] = i < (size_t)512 * 1024 ? bf2f(((const u16*)(p.ws + OFF_MIX))[(size_t)XTOK * 1024 + i]) : 0.f;
#elif DBG_DUMP == 9
    p.out[i] = i < (size_t)512 * 1024 ? ((const float*)(p.ws + OFF_XBUF))[(size_t)XTOK * 1024 + i] : 0.f;
#elif DBG_DUMP == 10
    p.out[i] = ((const float*)(p.ws + OFF_T))[i % ((size_t)8388608)];
#elif DBG_DUMP == 11
    p.out[i] = bf2f(((const u16*)(p.ws + OFF_WIN))[(size_t)3 * 2048 * 1024 + (i % ((size_t)2048 * 1024))]);
#elif DBG_DUMP == 13
    p.out[i] = bf2f(((const u16*)(p.ws + OFF_WIN))[(size_t)3 * 2048 * 1024 + (i % ((size_t)2048 * 1024))]) + ((const float*)(p.ws + OFF_MOD))[i % ((size_t)4 * 3 * 6144)];
#elif DBG_DUMP == 12
    p.out[i] = ((const float*)(p.ws + OFF_MOD))[i % ((size_t)4 * 3 * 6144)];
#elif DBG_DUMP == 1
    p.out[i] = ((const float*)(p.ws + OFF_XBUF))[i];
#elif DBG_DUMP == 2
    p.out[i] = bf2f(((const u16*)(p.ws + OFF_Q))[i % ((size_t)2*4*2*8192*64)]) + bf2f(((const u16*)(p.ws + OFF_K))[i % ((size_t)2*4*2*8448*64)]) + bf2f(((const u16*)(p.ws + OFF_VT))[i % ((size_t)2*4*8448*128)]);
#elif DBG_DUMP == 3
    p.out[i] = ((const float*)(p.ws + OFF_U))[i % ((size_t)NTOK*256)] + ((const float*)(p.ws + OFF_F))[i % ((size_t)NTOK*256)];
#elif DBG_DUMP == 4
    p.out[i] = bf2f(((const u16*)(p.ws + OFF_HGLU))[i % ((size_t)NTOK*256)]);
#endif
  }
}
#endif

extern "C" void kernel_launch(void* const* d_in, const int* in_sizes, int n_in, void* d_out, int out_size, void* d_ws, size_t ws_size,
                              hipStream_t stream) {
  static int grid_blocks = 0;
  if (!grid_blocks) {
    int dev = 0, cus = 0, per_cu = 0;
    hipGetDevice(&dev);
    hipDeviceGetAttribute(&cus, hipDeviceAttributeMultiprocessorCount, dev);
    hipOccupancyMaxActiveBlocksPerMultiprocessor(&per_cu, mega, 512, 0);
    if (per_cu < 1) per_cu = 1;
    if (per_cu > 1) per_cu = 1;
    grid_blocks = cus * per_cu;
  }
  if (ws_size < WS_NEED) { fprintf(stderr, "workspace too small: %zu < %zu\n", ws_size, (size_t)WS_NEED); return; }
  P p{};
  const float** pp = (const float**)&p;
  for (int i = 0; i < 30; ++i) pp[i] = (const float*)d_in[i];
  p.out = (float*)d_out;
  p.ws = (char*)d_ws;
#ifdef DBG_MEMSET
  hipMemsetAsync(d_ws, 0, WS_NEED, stream);
#endif
  hipMemsetAsync((char*)d_ws + OFF_BAR, 0, BAR_BYTES, stream);
#if COOP
#ifdef DBG_STOP
  int lo = 0, hi = DBG_STOP, coop = 1;
#else
  int lo = 0, hi = NPHASE, coop = 1;
#endif
  void* args[] = {&p, &lo, &hi, &coop};
  hipError_t e = hipLaunchCooperativeKernel((void*)mega, dim3(grid_blocks), dim3(512), args, 0, stream);
  if (e != hipSuccess) fprintf(stderr, "cooperative launch failed: %s (grid %d)\n", hipGetErrorString(e), grid_blocks);
#ifdef DBG_DUMP
  dumpk<<<dim3(1024), dim3(256), 0, stream>>>(p);
#endif
#else
#ifdef DBG_STOP
  for (int ph = 0; ph < DBG_STOP; ++ph) mega<<<dim3(grid_blocks), dim3(512), 0, stream>>>(p, ph, ph + 1, 0);
#else
  for (int ph = 0; ph < NPHASE; ++ph) mega<<<dim3(grid_blocks), dim3(512), 0, stream>>>(p, ph, ph + 1, 0);
#endif
#ifdef DBG_DUMP
  dumpk<<<dim3(1024), dim3(256), 0, stream>>>(p);
#endif
#endif
}
```

```cpp
#include <hip/hip_runtime.h>
#include <hip/hip_cooperative_groups.h>
#include <cstdio>
#include <cstdint>
namespace cg = cooperative_groups;

#ifndef COOP
#define COOP 1
#endif

#define DI __device__ __forceinline__
typedef unsigned short u16;
typedef short bf16x8 __attribute__((ext_vector_type(8)));
typedef float f32x4 __attribute__((ext_vector_type(4)));
typedef float f32x16 __attribute__((ext_vector_type(16)));
typedef __bf16 bf16v2 __attribute__((ext_vector_type(2)));
typedef float f32v2 __attribute__((ext_vector_type(2)));

constexpr int DM = 1024, NBATCH = 2, SEQ = 8192, DEPTH = 4, CTX = 256;
constexpr int XTOK = NBATCH * SEQ;
constexpr int NTOK = XTOK + NBATCH * CTX;
constexpr int LK = CTX + SEQ;
constexpr int NKT = LK / 32;
constexpr int NCH = LK / 32;
constexpr int DFF = 4096;
constexpr int LDS_BYTES = 77824;
constexpr float EPS = 1e-6f;
constexpr float LOG2E = 1.4426950408889634f;

constexpr size_t AL(size_t x) { return (x + 255) & ~(size_t)255; }
constexpr size_t OFF_WIN = 0;
constexpr size_t OFF_WOUT = OFF_WIN + AL((size_t)DEPTH * 2048 * 1024 * 2);
constexpr size_t OFF_WFF1 = OFF_WOUT + AL((size_t)DEPTH * 1024 * 1024 * 2);
constexpr size_t OFF_WFF2 = OFF_WFF1 + AL((size_t)DEPTH * 4096 * 1024 * 2);
constexpr size_t OFF_WGLU = OFF_WFF2 + AL((size_t)DEPTH * 4096 * 1024 * 2);
constexpr size_t OFF_XBUF = OFF_WGLU + AL((size_t)DEPTH * 256 * 256 * 2);
constexpr size_t OFF_MIX = OFF_XBUF + AL((size_t)NTOK * 1024 * 4);
constexpr size_t OFF_MOD = OFF_MIX + AL((size_t)NTOK * 1024 * 2);
constexpr size_t OFF_SMALL = OFF_MOD + AL((size_t)DEPTH * 3 * 6144 * 4);
constexpr size_t OFF_AB = OFF_SMALL + 256;
constexpr size_t OFF_AT = OFF_AB + AL((size_t)DEPTH * 2 * 16 * 64 * 2 * 4);
constexpr size_t OFF_BBAR = OFF_AT + AL((size_t)DEPTH * 2 * 16 * 64 * 2 * 4);
constexpr size_t OFF_CM = OFF_BBAR + AL((size_t)DEPTH * 2 * 16 * 64 * 32 * 4);
constexpr size_t OFF_ROPE = OFF_CM + AL((size_t)DEPTH * 2 * 16 * 16 * 128 * 2);
constexpr size_t OFF_D128 = OFF_ROPE + AL((size_t)192 * 16 * 8);
constexpr size_t OFF_D64 = OFF_D128 + AL((size_t)256 * 128 * 2);
constexpr size_t OFF_TW = OFF_D64 + AL((size_t)128 * 128 * 2);
constexpr size_t OFF_WCS = OFF_TW + AL((size_t)128 * 64 * 8);
constexpr size_t OFF_R1 = OFF_WCS + AL((size_t)DEPTH * 4 * 64 * 128 * 2);
constexpr size_t OFF_HID = OFF_R1;
constexpr size_t OFF_Q = OFF_R1;
constexpr size_t OFF_QC = OFF_Q + AL((size_t)2 * 4 * 2 * 8192 * 64 * 2);
constexpr size_t OFF_K = OFF_QC + AL((size_t)2 * 4 * 2 * 256 * 64 * 2);
constexpr size_t OFF_VT = OFF_K + AL((size_t)2 * 4 * 2 * LK * 64 * 2);
constexpr size_t OFF_U = OFF_VT + AL((size_t)2 * 4 * LK * 128 * 2);
constexpr size_t OFF_F = OFF_U + AL((size_t)NTOK * 256 * 4);
constexpr size_t OFF_LOCAL = OFF_F + AL((size_t)NTOK * 256 * 4);
constexpr size_t OFF_CARRY = OFF_LOCAL + AL((size_t)2 * 2 * NCH * 1024 * 8);
constexpr size_t OFF_T = OFF_CARRY + AL((size_t)2 * 2 * NCH * 1024 * 8);
constexpr size_t OFF_HGLU = OFF_T + AL((size_t)2 * 4 * 128 * 2 * 64 * 64 * 4);
constexpr size_t OFF_END_MIX = OFF_HGLU + AL((size_t)NTOK * 256 * 2);
constexpr size_t OFF_END_HID = OFF_HID + AL((size_t)NTOK * 4096 * 2);
constexpr size_t OFF_XCTX2 = OFF_END_MIX > OFF_END_HID ? OFF_END_MIX : OFF_END_HID;
constexpr size_t OFF_HN = OFF_XCTX2 + AL((size_t)NBATCH * CTX * 1024 * 4);
constexpr size_t OFF_BAR = OFF_HN + AL((size_t)NTOK * 1024 * 2);
constexpr size_t BAR_BYTES = 3456 * 4;
constexpr size_t OFF_BBH = OFF_BAR + AL(BAR_BYTES);
constexpr size_t WS_NEED = OFF_BBH + AL((size_t)DEPTH * 2 * 16 * 128 * 16 * 2);

struct P {
  const float *x, *c, *ctx, *c_ctx, *w_mod, *b_mod, *g_norm1, *w_in, *g_qnorm, *g_knorm, *lam_q1, *lam_k1, *lam_q2, *lam_k2,
      *g_subln, *ssm_a_re, *ssm_a_im, *ssm_log_dt, *ssm_b_re, *ssm_b_im, *ssm_c_re, *ssm_c_im, *ssm_d, *w_glu, *b_glu, *w_fnet,
      *w_out, *g_norm2, *w_ff1, *w_ff2;
  float* out;
  char* ws;
};

DI unsigned pk2(float a, float b) { f32v2 v = {a, b}; return __builtin_bit_cast(unsigned, __builtin_convertvector(v, bf16v2)); }
DI u16 bf1(float a) { return (u16)(pk2(a, 0.f) & 0xffffu); }
DI float bf2f(u16 h) { return __uint_as_float(((unsigned)h) << 16); }
DI f32x4 mfma16(bf16x8 a, bf16x8 b, f32x4 c) { return __builtin_amdgcn_mfma_f32_16x16x32_bf16(a, b, c, 0, 0, 0); }
DI f32x16 mfma32(bf16x8 a, bf16x8 b, f32x16 c) { return __builtin_amdgcn_mfma_f32_32x32x16_bf16(a, b, c, 0, 0, 0); }
DI float silu(float v) { return v / (1.f + __expf(-v)); }
DI float gelu_tanh(float v) { float t = 0.7978845608028654f * (v + 0.044715f * v * v * v); return 0.5f * v * (1.f + tanhf(t)); }
DI int get_tid() { int t = threadIdx.x & 255; asm volatile("" : "+v"(t)); return t; }
DI void opaque_zero2(float& a, float& b) { asm volatile("v_mov_b32 %0, 0\n\tv_mov_b32 %1, 0" : "=v"(a), "=v"(b)); }
DI float* xa_tile(const P& p, int mt) { return (float*)(p.ws + OFF_XBUF) + (size_t)mt * 128 * 1024; }
DI const float* xa_rd_tile(const P& p, int layer, int mt) {
  if (layer == 0) return mt < 128 ? p.x + (size_t)mt * 128 * 1024 : p.ctx + (size_t)(mt - 128) * 128 * 1024;
  return (const float*)(p.ws + OFF_XBUF) + (size_t)mt * 128 * 1024;
}
DI float* xb_tile(const P& p, int mt) { return mt < 128 ? p.out + (size_t)mt * 128 * 1024 : (float*)(p.ws + OFF_XCTX2) + (size_t)(mt - 128) * 128 * 1024; }
DI float lam_init_of(int layer) { return 0.8f - 0.6f * expf(-0.3f * (float)layer); }

DI void tr_unit(const float* __restrict__ src, u16* __restrict__ dst, int K, int N, int u, char* smem) {
  float* t = (float*)smem;
  const int tid = get_tid();
  const int tnN = N / 64, tk = u / tnN, tn = u % tnN;
  __syncthreads();
#pragma unroll
  for (int i = 0; i < 4; ++i) {
    const int k = (tid >> 4) + 16 * i, n4 = (tid & 15) * 4;
    *(float4*)(t + k * 68 + n4) = *(const float4*)(src + (size_t)(tk * 64 + k) * N + tn * 64 + n4);
  }
  __syncthreads();
#pragma unroll
  for (int i = 0; i < 2; ++i) {
    const int item = tid + 256 * i, n = item >> 3, kb = (item & 7) * 8;
    const float* tp = t + kb * 68 + n;
    uint4 o;
    o.x = pk2(tp[0], tp[68]); o.y = pk2(tp[2 * 68], tp[3 * 68]); o.z = pk2(tp[4 * 68], tp[5 * 68]); o.w = pk2(tp[6 * 68], tp[7 * 68]);
    *(uint4*)(dst + (size_t)(tn * 64 + n) * K + tk * 64 + kb) = o;
  }
}

DI void prep_transposes(const P& p, int u, char* smem) {
  const int l = u / 2832; int r = u % 2832;
  char* ws = p.ws;
  if (r < 512) { tr_unit(p.w_in + (size_t)l * 1024 * 2048, (u16*)(ws + OFF_WIN) + (size_t)l * 2048 * 1024, 1024, 2048, r, smem); return; }
  r -= 512;
  if (r < 256) { tr_unit(p.w_out + (size_t)l * 1024 * 1024, (u16*)(ws + OFF_WOUT) + (size_t)l * 1024 * 1024, 1024, 1024, r, smem); return; }
  r -= 256;
  if (r < 1024) { tr_unit(p.w_ff1 + (size_t)l * 1024 * 4096, (u16*)(ws + OFF_WFF1) + (size_t)l * 4096 * 1024, 1024, 4096, r, smem); return; }
  r -= 1024;
  if (r < 1024) { tr_unit(p.w_ff2 + (size_t)l * 4096 * 1024, (u16*)(ws + OFF_WFF2) + (size_t)l * 1024 * 4096, 4096, 1024, r, smem); return; }
  r -= 1024;
  tr_unit(p.w_glu + (size_t)l * 256 * 256, (u16*)(ws + OFF_WGLU) + (size_t)l * 256 * 256, 256, 256, r, smem);
}

DI void prep_copy(const P& p, int u) {
  float4* dst = (float4*)(p.ws + OFF_XBUF);
  const float4* sx = (const float4*)p.x; const float4* sc = (const float4*)p.ctx;
  const size_t nx4 = (size_t)XTOK * 256;
const int tid = get_tid();
#pragma unroll 4
  for (int i = 0; i < 16; ++i) {
    const size_t idx = (size_t)u * 4096 + i * 256 + tid;
    dst[idx] = idx < nx4 ? sx[idx] : sc[idx - nx4];
  }
}

DI void prep_mod(const P& p, int u, char* smem) {
  float* act = (float*)smem;
  float* red = act + 3072;
  const int tid = get_tid();
  const int l = u / 96, jb = u % 96;
  __syncthreads();
  for (int i = tid; i < 3072; i += 256) {
    const int r = i >> 10, k = i & 1023;
    const float v = r < 2 ? p.c[r * 1024 + k] : p.c_ctx[k];
    act[i] = silu(v);
  }
  __syncthreads();
  const int j = jb * 64 + (tid & 63), kg = tid >> 6;
  float a0 = 0.f, a1 = 0.f, a2 = 0.f;
  const float* wp = p.w_mod + (size_t)l * 1024 * 6144 + j;
#pragma unroll 32
  for (int k = kg * 256; k < kg * 256 + 256; ++k) {
    const float wv = wp[(size_t)k * 6144];
    a0 += act[k] * wv; a1 += act[1024 + k] * wv; a2 += act[2048 + k] * wv;
  }
  red[(kg * 3 + 0) * 64 + (tid & 63)] = a0; red[(kg * 3 + 1) * 64 + (tid & 63)] = a1; red[(kg * 3 + 2) * 64 + (tid & 63)] = a2;
  __syncthreads();
  if (tid < 192) {
    const int r = tid >> 6, jj = tid & 63;
    float s = p.b_mod[l * 6144 + jb * 64 + jj];
    for (int q = 0; q < 4; ++q) s += red[(q * 3 + r) * 64 + jj];
    ((float*)(p.ws + OFF_MOD))[((size_t)l * 3 + r) * 6144 + jb * 64 + jj] = s;
  }
}

DI void prep_disc(const P& p, int u) {
  const int idx = u * 256 + get_tid();
  const int g = (idx >> 6) & 15;
  const int ld = idx >> 10;
  const float are = p.ssm_a_re[idx], aim = p.ssm_a_im[idx];
  const float dt = expf(p.ssm_log_dt[ld * 16 + g]);
  const float mag = expf(dt * are);
  const float abr = mag * cosf(dt * aim), abi = mag * sinf(dt * aim);
  const float den = are * are + aim * aim, nre = abr - 1.f;
  const float fre = (nre * are + abi * aim) / den, fim = (abi * are - nre * aim) / den;
  float2* AB = (float2*)(p.ws + OFF_AB); float2* AT = (float2*)(p.ws + OFF_AT);
  AB[idx] = make_float2(abr, abi);
  float tr = abr, ti = abi;
#pragma unroll
  for (int i = 0; i < 5; ++i) { const float nr = tr * tr - ti * ti, ni = 2.f * tr * ti; tr = nr; ti = ni; }
  AT[idx] = make_float2(tr, ti);
  float* bb = (float*)(p.ws + OFF_BBAR) + (size_t)idx * 32;
  const float* bre = p.ssm_b_re + (size_t)idx * 16; const float* bim = p.ssm_b_im + (size_t)idx * 16;
  for (int q = 0; q < 16; ++q) {
    const float br = bre[q], bi = bim[q];
    bb[q] = fre * br - fim * bi; bb[16 + q] = fre * bi + fim * br;
    u16* bh = (u16*)(p.ws + OFF_BBH) + ((size_t)(ld * 16 + g) * 128 + 2 * (idx & 63)) * 16;
    bh[q] = bf1(fre * br - fim * bi); bh[16 + q] = bf1(fre * bi + fim * br);
  }
}

DI void prep_tables(const P& p, int u) {
  const int i = u * 256 + get_tid();
  const float TWO_PI = 6.283185307179586f;
  char* ws = p.ws;
  if (i < 3072) {
    const int pos = i >> 4, j = i & 15;
    const float inv = powf(10000.f, -(float)j / 16.f);
    const float ang = (float)(pos < 128 ? pos : pos - 128) * inv;
    ((float2*)(ws + OFF_ROPE))[i] = make_float2(cosf(ang), sinf(ang));
    return;
  }
  int r = i - 3072;
  if (r < 32768) {
    const int row = r >> 7, rr = r & 127, ri = row >> 7, k1 = row & 127;
    const float ang = TWO_PI * (float)((k1 * rr) & 127) / 128.f;
    ((u16*)(ws + OFF_D128))[r] = bf1(ri == 0 ? cosf(ang) : -sinf(ang));
    return;
  }
  r -= 32768;
  if (r < 16384) {
    const int row = r >> 7, kx = r & 127, ri = row >> 6, k2 = row & 63, xri = kx >> 6, col = kx & 63;
    const float ang = TWO_PI * (float)((k2 * col) & 63) / 64.f;
    const float cr = cosf(ang), sr = sinf(ang);
    const float v = ri == 0 ? (xri == 0 ? cr : sr) : (xri == 0 ? -sr : cr);
    ((u16*)(ws + OFF_D64))[r] = bf1(v);
    return;
  }
  r -= 16384;
  if (r < 8192) {
    const int k1 = r >> 6, col = r & 63;
    const float ang = TWO_PI * (float)(k1 * col) / 8192.f;
    ((float2*)(ws + OFF_TW))[r] = make_float2(cosf(ang), -sinf(ang));
    return;
  }
  r -= 8192;
  if (r < DEPTH) {
    const int l = r;
    float s1 = 0.f, s2 = 0.f, gq = 0.f, gk = 0.f;
    for (int q = 0; q < 64; ++q) {
      s1 += p.lam_q1[l * 64 + q] * p.lam_k1[l * 64 + q]; s2 += p.lam_q2[l * 64 + q] * p.lam_k2[l * 64 + q];
      gq = fmaxf(gq, fabsf(p.g_qnorm[l * 64 + q])); gk = fmaxf(gk, fabsf(p.g_knorm[l * 64 + q]));
    }
    float* sm = (float*)(ws + OFF_SMALL);
    sm[l] = expf(s1) - expf(s2) + lam_init_of(l);
    sm[4 + l] = 8.f * gq * gk * LOG2E;
  }
}
constexpr int N_TABLE_UNITS = (3072 + 32768 + 16384 + 8192 + DEPTH + 255) / 256;

DI void prep_wcs(const P& p, int u) {
  const int idx = u * 256 + get_tid();
  const int k = idx & 127, d = (idx >> 7) & 63, lg = idx >> 13;
  const int ri = k >> 6, c = k & 63;
  const float* wf = p.w_fnet + (size_t)lg * 4096;
  float s = 0.f;
  for (int cp = 0; cp < 64; ++cp) {
    const float ang = 6.283185307179586f * (float)((c * cp) & 63) / 64.f;
    s += (ri == 0 ? cosf(ang) : sinf(ang)) * wf[cp * 64 + d];
  }
  ((u16*)(p.ws + OFF_WCS))[idx] = bf1(s * (1.f / 724.0773439350247f));
}

DI void prep_cm(const P& p, int u) {
  const int idx = u * 256 + get_tid();
  const int k = idx & 127, row = idx >> 7;
  const float v = k < 64 ? p.ssm_c_re[(size_t)row * 64 + k] : -p.ssm_c_im[(size_t)row * 64 + (k - 64)];
  ((u16*)(p.ws + OFF_CM))[idx] = bf1(v);
}


DI void norm_unit(const P& p, int layer, int which, int u) {
  const int tid = get_tid(), lane = tid & 63;
  const int r = u * 8 + (tid >> 6);
  const int mt = r >> 7;
  const float* xrow = (which == 0 ? xa_rd_tile(p, layer, mt) : (const float*)xb_tile(p, mt)) + (size_t)(r & 127) * 1024 + lane * 4;
  const float* modl = (const float*)(p.ws + OFF_MOD) + ((size_t)layer * 3 + (r < XTOK ? (r >> 13) : 2)) * 6144 + lane * 4;
  const float* sh = modl + (which == 0 ? 0 : 3072);
  const float* sc = modl + (which == 0 ? 1024 : 4096);
  const float* gn = (which == 0 ? p.g_norm1 : p.g_norm2) + layer * 1024 + lane * 4;
  const float4 v0 = *(const float4*)(xrow), v1 = *(const float4*)(xrow + 256), v2 = *(const float4*)(xrow + 512), v3 = *(const float4*)(xrow + 768);
  const float4 w0 = *(const float4*)(xrow + 4096), w1 = *(const float4*)(xrow + 4096 + 256), w2 = *(const float4*)(xrow + 4096 + 512), w3 = *(const float4*)(xrow + 4096 + 768);
  float4 g0 = *(const float4*)(gn), g1 = *(const float4*)(gn + 256), g2 = *(const float4*)(gn + 512), g3 = *(const float4*)(gn + 768);
  const float4 s0 = *(const float4*)(sc), s1 = *(const float4*)(sc + 256), s2 = *(const float4*)(sc + 512), s3 = *(const float4*)(sc + 768);
  const float4 h0 = *(const float4*)(sh), h1 = *(const float4*)(sh + 256), h2 = *(const float4*)(sh + 512), h3 = *(const float4*)(sh + 768);
#define SSQ4(V) (V.x * V.x + V.y * V.y + V.z * V.z + V.w * V.w)
  float ssa = SSQ4(v0) + SSQ4(v1) + SSQ4(v2) + SSQ4(v3), ssb = SSQ4(w0) + SSQ4(w1) + SSQ4(w2) + SSQ4(w3);
#undef SSQ4
#pragma unroll
  for (int o = 1; o < 64; o <<= 1) { ssa += __shfl_xor(ssa, o); ssb += __shfl_xor(ssb, o); }
  const float ra = rsqrtf(ssa * (1.f / 1024.f) + EPS), rb = rsqrtf(ssb * (1.f / 1024.f) + EPS);
  g0.x *= 1.f + s0.x; g0.y *= 1.f + s0.y; g0.z *= 1.f + s0.z; g0.w *= 1.f + s0.w;
  g1.x *= 1.f + s1.x; g1.y *= 1.f + s1.y; g1.z *= 1.f + s1.z; g1.w *= 1.f + s1.w;
  g2.x *= 1.f + s2.x; g2.y *= 1.f + s2.y; g2.z *= 1.f + s2.z; g2.w *= 1.f + s2.w;
  g3.x *= 1.f + s3.x; g3.y *= 1.f + s3.y; g3.z *= 1.f + s3.z; g3.w *= 1.f + s3.w;
  u16* dst = (u16*)(p.ws + OFF_HN) + (size_t)r * 1024 + lane * 4;
#define NORM_ST(V, RS, Gv, Hv, OFS) do { uint2 o; \
    o.x = pk2(V.x * RS * Gv.x + Hv.x, V.y * RS * Gv.y + Hv.y); \
    o.y = pk2(V.z * RS * Gv.z + Hv.z, V.w * RS * Gv.w + Hv.w); \
    *(uint2*)(dst + (OFS)) = o; } while (0)
  NORM_ST(v0, ra, g0, h0, 0); NORM_ST(v1, ra, g1, h1, 256); NORM_ST(v2, ra, g2, h2, 512); NORM_ST(v3, ra, g3, h3, 768);
  NORM_ST(w0, rb, g0, h0, 4096); NORM_ST(w1, rb, g1, h1, 4096 + 256); NORM_ST(w2, rb, g2, h2, 4096 + 512); NORM_ST(w3, rb, g3, h3, 4096 + 768);
#undef NORM_ST
}

enum { EPI_PROJ = 0, EPI_OUT = 1, EPI_FF1 = 2, EPI_FF2 = 3, EPI_GLU = 4 };
constexpr int LDT = 72;

template <int AMODE, int EPI>
DI void gemm_unit(const P& p, int layer, int mt, int nt, int K, const u16* __restrict__ Wt, const void* __restrict__ Asrc, int lda,
                  const float* gn, const float* sc, const float* sh, char* smem, bool dup, int role = -1, char* smem_other = nullptr) {
  const int tid = get_tid(), lane = tid & 63, w = tid >> 6, wr = w >> 1, wc = w & 1, fr = lane & 15, fq = lane >> 4;
  u16* As = (u16*)smem;
  u16* Bs = As + 2 * 128 * LDT;
  float* rs = (float*)(Bs + 2 * 128 * LDT);
  const int rmod = mt < 128 ? (mt >> 6) : 2;
  const float* modl = (const float*)(p.ws + OFF_MOD) + ((size_t)layer * 3 + rmod) * 6144;
  __syncthreads();
  f32x4 acc[4][4];
#pragma unroll
  for (int m = 0; m < 4; ++m)
#pragma unroll
    for (int n = 0; n < 4; ++n) acc[m][n] = (f32x4){0.f, 0.f, 0.f, 0.f};

  uint4 p0, p1, p2, p3, q0, q1, q2, q3;
  uint4 r0, r1, r2, r3, t0, t1, t2, t3;
  uint4 x0, x1, x2, x3, z0, z1, z2, z3;
  const int nk = role > 0 ? K / 128 : K / 64;
  const int kofs = role == 2 ? K / 2 : 0;
  const bool share = role == 0;
  const bool hi = share && smem_other < smem;
  const u16* Ag = (const u16*)Asrc + (size_t)(mt * 128 + (share && hi ? 64 : 0) + (tid >> 3)) * lda + (tid & 7) * 8 + kofs;
  const u16* afb = share ? ((wr == (hi ? 1 : 0)) ? As : (const u16*)smem_other) : As + wr * 64 * LDT;
  const u16* Bg = Wt + (size_t)(nt * 128 + (tid >> 3)) * K + (tid & 7) * 8 + kofs;
  const int lrow = ((tid >> 3)) * LDT + (tid & 7) * 8;
#define GLOAD(A0, A1, A2, A3, B0, B1, B2, B3, kt)                                                 \
  do {                                                                                            \
    B0 = *(const uint4*)(Bg + (kt) * 64); B1 = *(const uint4*)(Bg + (size_t)32 * K + (kt) * 64);  \
    B2 = *(const uint4*)(Bg + (size_t)64 * K + (kt) * 64); B3 = *(const uint4*)(Bg + (size_t)96 * K + (kt) * 64); \
    A0 = *(const uint4*)(Ag + (kt) * 64); A1 = *(const uint4*)(Ag + (size_t)32 * lda + (kt) * 64); \
    if (!share) { A2 = *(const uint4*)(Ag + (size_t)64 * lda + (kt) * 64); A3 = *(const uint4*)(Ag + (size_t)96 * lda + (kt) * 64); } \
  } while (0)
#define LSTORE(A0, A1, A2, A3, B0, B1, B2, B3, buf)                                               \
  do {                                                                                            \
    u16* bs_ = Bs + (buf) * 128 * LDT + lrow; u16* as_ = As + (buf) * 128 * LDT + lrow;          \
    *(uint4*)(bs_) = B0; *(uint4*)(bs_ + 32 * LDT) = B1; *(uint4*)(bs_ + 64 * LDT) = B2; *(uint4*)(bs_ + 96 * LDT) = B3; \
    *(uint4*)(as_) = A0; *(uint4*)(as_ + 32 * LDT) = A1; if (!share) { *(uint4*)(as_ + 64 * LDT) = A2; *(uint4*)(as_ + 96 * LDT) = A3; } \
  } while (0)
#define ST0 p0, p1, p2, p3, q0, q1, q2, q3
#define ST1 r0, r1, r2, r3, t0, t1, t2, t3
#define ST2 x0, x1, x2, x3, z0, z1, z2, z3
#define GLOAD_(...) GLOAD(__VA_ARGS__)
#define LSTORE_(...) LSTORE(__VA_ARGS__)
#define COMPUTE(buf)                                                                              \
  do {                                                                                            \
    _Pragma("unroll") for (int kk = 0; kk < 2; ++kk) {                                            \
      bf16x8 af[4], wf[4];                                                                        \
      _Pragma("unroll") for (int m = 0; m < 4; ++m) af[m] = *(const bf16x8*)(afb + (buf) * 128 * LDT + (m * 16 + fr) * LDT + kk * 32 + fq * 8); \
      _Pragma("unroll") for (int n = 0; n < 4; ++n) wf[n] = *(const bf16x8*)(Bs + (buf) * 128 * LDT + (wc * 64 + n * 16 + fr) * LDT + kk * 32 + fq * 8); \
      _Pragma("unroll") for (int m = 0; m < 4; ++m)                                               \
        _Pragma("unroll") for (int n = 0; n < 4; ++n) acc[m][n] = mfma16(wf[n], af[m], acc[m][n]); \
    }                                                                                             \
  } while (0)

#define STEP(SL, SS, buf, i)                                          \
  if (kt + (i) < nk) {                                                \
    if (kt + (i) + 3 < nk) GLOAD_(SL, kt + (i) + 3);                  \
    COMPUTE(buf);                                                     \
    if (kt + (i) + 1 < nk) LSTORE_(SS, (buf) ^ 1);                    \
    __syncthreads();                                                  \
  }
  GLOAD_(ST0, 0);
  GLOAD_(ST1, 1);
  if (nk > 2) GLOAD_(ST2, 2);
  LSTORE_(ST0, 0);
  __syncthreads();
  for (int kt = 0; kt < nk; kt += 6) {
    STEP(ST0, ST1, 0, 0)
    STEP(ST1, ST2, 1, 1)
    STEP(ST2, ST0, 0, 2)
    STEP(ST0, ST1, 1, 3)
    STEP(ST1, ST2, 0, 4)
    STEP(ST2, ST0, 1, 5)
  }
#undef STEP
#undef GLOAD
#undef LSTORE
#undef COMPUTE
#undef ST0
#undef ST1
#undef ST2
#undef GLOAD_
#undef LSTORE_
  if (role > 0) {
    if (role == 2) {
#pragma unroll
      for (int m = 0; m < 4; ++m)
#pragma unroll
        for (int n = 0; n < 4; ++n) *(f32x4*)(smem + ((size_t)((m * 4 + n) * 256 + tid)) * 16) = acc[m][n];
    }
    __syncthreads();
    if (role == 2) return;
#pragma unroll
    for (int m = 0; m < 4; ++m)
#pragma unroll
      for (int n = 0; n < 4; ++n) acc[m][n] = acc[m][n] + *(const f32x4*)(smem_other + ((size_t)((m * 4 + n) * 256 + tid)) * 16);
  }

  if (dup) return;
  const int tok0 = mt * 128 + wr * 64 + fr;
  const int f0 = nt * 128 + wc * 64 + fq * 4;
  char* ws = p.ws;
  if (EPI == EPI_PROJ) {
    const bool isctx = mt >= 128;
    if (nt < 8) {
      const int grp = nt * 2 + wc; const bool isK = grp >= 8; const int gi = grp & 7, hh = gi >> 1, mp = gi & 1;
      const float* gw = (isK ? p.g_knorm : p.g_qnorm) + layer * 64;
      float gwv[4][4];
#pragma unroll
      for (int n = 0; n < 4; ++n) { const float4 t = *(const float4*)(gw + n * 16 + fq * 4); gwv[n][0] = t.x; gwv[n][1] = t.y; gwv[n][2] = t.z; gwv[n][3] = t.w; }
      const float2* rope = (const float2*)(ws + OFF_ROPE);
      const float osc = isK ? 1.f : 0.125f * LOG2E;
#pragma unroll
      for (int m = 0; m < 4; ++m) {
        const int tok = tok0 + m * 16;
        float ss = 0.f;
#pragma unroll
        for (int n = 0; n < 4; ++n)
#pragma unroll
          for (int j = 0; j < 4; ++j) ss += acc[m][n][j] * acc[m][n][j];
        ss += __shfl_xor(ss, 16); ss += __shfl_xor(ss, 32);
        const float rstd = rsqrtf(ss * (1.f / 64.f) + EPS);
        float v[4][4];
#pragma unroll
        for (int n = 0; n < 4; ++n)
#pragma unroll
          for (int j = 0; j < 4; ++j) v[n][j] = acc[m][n][j] * rstd * gwv[n][j];
        u16* dst;
        if (!isctx) {
          const int b = tok >> 13, t = tok & 8191, prow = t >> 6, pcol = t & 63;
#pragma unroll
          for (int n = 0; n < 2; ++n) {
            const float2* rp = rope + (size_t)(n == 0 ? prow : 128 + pcol) * 16 + fq * 4;
#pragma unroll
            for (int j = 0; j < 4; ++j) {
              const float2 cs = rp[j];
              const float x1 = v[n][j], x2 = v[n + 2][j];
              v[n][j] = x1 * cs.x - x2 * cs.y; v[n + 2][j] = x2 * cs.x + x1 * cs.y;
            }
          }
          if (isK) dst = (u16*)(ws + OFF_K) + ((size_t)((b * 4 + hh) * 2 + mp) * LK + 256 + t) * 64;
          else dst = (u16*)(ws + OFF_Q) + ((size_t)((b * 4 + hh) * 2 + mp) * 8192 + t) * 64;
        } else {
          const int tc = tok - XTOK, b = tc >> 8, t = tc & 255;
          if (isK) dst = (u16*)(ws + OFF_K) + ((size_t)((b * 4 + hh) * 2 + mp) * LK + t) * 64;
          else dst = (u16*)(ws + OFF_QC) + ((size_t)((b * 4 + hh) * 2 + mp) * 256 + t) * 64;
        }
#pragma unroll
        for (int n = 0; n < 4; ++n) {
          uint2 o; o.x = pk2(v[n][0] * osc, v[n][1] * osc); o.y = pk2(v[n][2] * osc, v[n][3] * osc);
          *(uint2*)(dst + n * 16 + fq * 4) = o;
        }
      }
    } else if (nt < 12) {
      const int hh = nt - 8;
      u16* vt = (u16*)(ws + OFF_VT);
#pragma unroll
      for (int m = 0; m < 4; ++m) {
        const int tok = tok0 + m * 16;
        int b, key;
        if (!isctx) { b = tok >> 13; key = 256 + (tok & 8191); } else { const int tc = tok - XTOK; b = tc >> 8; key = tc & 255; }
        const size_t base = ((size_t)(b * 4 + hh) * NKT + (key >> 5)) * 128 * 32 + (key & 31);
#pragma unroll
        for (int n = 0; n < 4; ++n)
#pragma unroll
          for (int j = 0; j < 4; ++j) { const int dv = wc * 64 + n * 16 + fq * 4 + j; vt[base + (size_t)dv * 32] = bf1(acc[m][n][j]); }
      }
    } else {
      float* dstb = (float*)(ws + (nt < 14 ? OFF_U : OFF_F));
      const int c0 = (nt & 1) * 128 + wc * 64 + fq * 4;
#pragma unroll
      for (int m = 0; m < 4; ++m) {
        const int tok = tok0 + m * 16;
#pragma unroll
        for (int n = 0; n < 4; ++n) *(f32x4*)(dstb + (size_t)tok * 256 + c0 + n * 16) = acc[m][n];
      }
    }
  } else if (EPI == EPI_OUT || EPI == EPI_FF2) {
    const float* gate = modl + (EPI == EPI_OUT ? 2048 : 5120);
    const bool last = (EPI == EPI_FF2) && (layer == DEPTH - 1);
    const float* xin = (EPI == EPI_OUT) ? xa_rd_tile(p, layer, mt) : (const float*)xb_tile(p, mt);
    float* xout = (EPI == EPI_OUT || last) ? xb_tile(p, mt) : xa_tile(p, mt);
#pragma unroll
    for (int m = 0; m < 4; ++m) {
      const int lrow = wr * 64 + m * 16 + fr;
#pragma unroll
      for (int n = 0; n < 4; ++n) {
        const int f = f0 + n * 16;
        const f32x4 gv = *(const f32x4*)(gate + f);
        f32x4 xv = *(const f32x4*)(xin + (size_t)lrow * 1024 + f);
        xv = xv + gv * acc[m][n];
        *(f32x4*)(xout + (size_t)lrow * 1024 + f) = xv;
      }
    }
  } else if (EPI == EPI_FF1) {
    u16* hid = (u16*)(ws + OFF_HID);
#pragma unroll
    for (int m = 0; m < 4; ++m) {
      const int tok = tok0 + m * 16;
#pragma unroll
      for (int n = 0; n < 4; ++n) {
        f32x4 a = acc[m][n];
#pragma unroll
        for (int j = 0; j < 4; ++j) { const float r = fmaxf(a[j], 0.f); a[j] = r * r; }
        uint2 o; o.x = pk2(a[0], a[1]); o.y = pk2(a[2], a[3]);
        *(uint2*)(hid + (size_t)tok * DFF + f0 + n * 16) = o;
      }
    }
  } else if (EPI == EPI_GLU) {
    const u16* hg = (const u16*)(ws + OFF_HGLU);
    u16* mix = (u16*)(ws + OFF_MIX);
    const float* bg = p.b_glu + layer * 256;
#pragma unroll
    for (int m = 0; m < 4; ++m) {
      const int tok = tok0 + m * 16;
#pragma unroll
      for (int n = 0; n < 4; ++n) {
        const int f = f0 + n * 16;
        const uint2 hv = *(const uint2*)(hg + (size_t)tok * 256 + f);
        const f32x4 bv = *(const f32x4*)(bg + f);
        float h[4] = {bf2f((u16)(hv.x & 0xffff)), bf2f((u16)(hv.x >> 16)), bf2f((u16)(hv.y & 0xffff)), bf2f((u16)(hv.y >> 16))};
        float o[4];
#pragma unroll
        for (int j = 0; j < 4; ++j) { const float z = acc[m][n][j] + bv[j]; o[j] = h[j] / (1.f + __expf(-z)); }
        uint2 ov; ov.x = pk2(o[0], o[1]); ov.y = pk2(o[2], o[3]);
        *(uint2*)(mix + (size_t)tok * 1024 + 512 + f) = ov;
      }
    }
  }
}

DI void attn_unit(const P& p, int layer, int u, char* smem) {
  const int tid = get_tid(), lane = tid & 63, w = tid >> 6, l32 = lane & 31, hf = lane >> 5;
  char* ws = p.ws;
  int b, hh, qb, nkt, lq; const u16* Qsrc; int tokbase;
  if (u < 512) { b = u >> 8; hh = (u >> 6) & 3; qb = u & 63; nkt = NKT; lq = 8192; Qsrc = (const u16*)(ws + OFF_Q); tokbase = b * 8192 + qb * 128; }
  else { const int uu = u - 512; b = uu >> 3; hh = (uu >> 1) & 3; qb = uu & 1; nkt = 8; lq = 256; Qsrc = (const u16*)(ws + OFF_QC); tokbase = XTOK + b * 256 + qb * 128; }
  const u16* Q0 = Qsrc + ((size_t)((b * 4 + hh) * 2) * lq + qb * 128) * 64;
  const u16* K0 = (const u16*)(ws + OFF_K) + (size_t)((b * 4 + hh) * 2) * LK * 64;
  const u16* V0 = (const u16*)(ws + OFF_VT) + (size_t)(b * 4 + hh) * NKT * 4096;
  u16* Qs = (u16*)smem;
  u16* KV = Qs + 2 * 128 * LDT;
  constexpr int KVSTRIDE = 2 * 32 * LDT + 128 * 40;
  const float lam = ((const float*)(ws + OFF_SMALL))[layer];
  __syncthreads();
#pragma unroll
  for (int i = 0; i < 8; ++i) {
    const int pi = tid + 256 * i;
    const int mp = pi >> 10, row = (pi >> 3) & 127, seg = pi & 7;
    *(uint4*)(Qs + (mp * 128 + row) * LDT + seg * 8) = *(const uint4*)(Q0 + (size_t)mp * lq * 64 + row * 64 + seg * 8);
  }
  uint4 kr0, kr1, vr0, vr1;
#define AGLOAD(kt)                                                                         \
  do {                                                                                     \
    kr0 = *(const uint4*)(K0 + (size_t)(kt) * 2048 + tid * 8);                             \
    kr1 = *(const uint4*)(K0 + (size_t)LK * 64 + (size_t)(kt) * 2048 + tid * 8);           \
    vr0 = *(const uint4*)(V0 + (size_t)(kt) * 4096 + tid * 8);                             \
    vr1 = *(const uint4*)(V0 + (size_t)(kt) * 4096 + 2048 + tid * 8);                      \
  } while (0)
#define ALSTORE(buf)                                                                       \
  do {                                                                                     \
    u16* kb = KV + (buf) * KVSTRIDE;                                                       \
    *(uint4*)(kb + (tid >> 3) * LDT + (tid & 7) * 8) = kr0;                                \
    *(uint4*)(kb + 32 * LDT + (tid >> 3) * LDT + (tid & 7) * 8) = kr1;                     \
    u16* vb = kb + 2 * 32 * LDT;                                                           \
    *(uint4*)(vb + (tid >> 2) * 40 + (tid & 3) * 8) = vr0;                                 \
    *(uint4*)(vb + (64 + (tid >> 2)) * 40 + (tid & 3) * 8) = vr1;                          \
  } while (0)
  AGLOAD(0);
  ALSTORE(0);
  __syncthreads();

  f32x16 o1[4], o2[4];
#pragma unroll
  for (int i = 0; i < 4; ++i)
#pragma unroll
    for (int j = 0; j < 16; ++j) { o1[i][j] = 0.f; o2[i][j] = 0.f; }
  float l1 = 0.f, l2 = 0.f;
  const u16* qrow = Qs + (w * 32 + l32) * LDT + hf * 8;

  const bf16x8 qa0 = *(const bf16x8*)(qrow), qa1 = *(const bf16x8*)(qrow + 16);
  for (int kt = 0; kt < nkt; ++kt) {
    const int buf = kt & 1;
    if (kt + 1 < nkt) AGLOAD(kt + 1);
    const u16* kb = KV + buf * KVSTRIDE;
    const u16* vb = kb + 2 * 32 * LDT;
    f32x16 s1, s2;
#pragma unroll
    for (int j = 0; j < 16; ++j) { s1[j] = 0.f; s2[j] = 0.f; }
#pragma unroll
    for (int kk = 0; kk < 4; ++kk) {
      const bf16x8 kf1 = *(const bf16x8*)(kb + l32 * LDT + kk * 16 + hf * 8);
      s1 = mfma32(kf1, kk == 0 ? qa0 : (kk == 1 ? qa1 : *(const bf16x8*)(qrow + kk * 16)), s1);
      const bf16x8 kf2 = *(const bf16x8*)(kb + 32 * LDT + l32 * LDT + kk * 16 + hf * 8);
      const bf16x8 qf2 = *(const bf16x8*)(qrow + 128 * LDT + kk * 16);
      s2 = mfma32(kf2, qf2, s2);
    }
    bf16x8 pf1[2], pf2[2];
    {
      unsigned pk[8], pq[8];
#pragma unroll
      for (int j = 0; j < 8; ++j) {
        const float a0 = __builtin_amdgcn_exp2f(s1[2 * j]), a1 = __builtin_amdgcn_exp2f(s1[2 * j + 1]);
        const float c0 = __builtin_amdgcn_exp2f(s2[2 * j]), c1 = __builtin_amdgcn_exp2f(s2[2 * j + 1]);
        l1 += a0 + a1; l2 += c0 + c1;
        pk[j] = pk2(a0, a1); pq[j] = pk2(c0, c1);
      }
      typedef unsigned u32x4 __attribute__((ext_vector_type(4)));
      pf1[0] = __builtin_bit_cast(bf16x8, (u32x4){pk[0], pk[1], pk[2], pk[3]});
      pf1[1] = __builtin_bit_cast(bf16x8, (u32x4){pk[4], pk[5], pk[6], pk[7]});
      pf2[0] = __builtin_bit_cast(bf16x8, (u32x4){pq[0], pq[1], pq[2], pq[3]});
      pf2[1] = __builtin_bit_cast(bf16x8, (u32x4){pq[4], pq[5], pq[6], pq[7]});
    }
#pragma unroll
    for (int blk = 0; blk < 4; ++blk) {
#pragma unroll
      for (int s = 0; s < 2; ++s) {
        const u16* vp = vb + (blk * 32 + l32) * 40 + 16 * s + 4 * hf;
        const uint2 lo = *(const uint2*)vp, hi = *(const uint2*)(vp + 8);
        typedef unsigned u32x4 __attribute__((ext_vector_type(4)));
        const bf16x8 vf = __builtin_bit_cast(bf16x8, (u32x4){lo.x, lo.y, hi.x, hi.y});
        o1[blk] = mfma32(vf, pf1[s], o1[blk]);
        o2[blk] = mfma32(vf, pf2[s], o2[blk]);
      }
    }
    if (kt + 1 < nkt) ALSTORE(buf ^ 1);
    __syncthreads();
  }
#undef AGLOAD
#undef ALSTORE
  l1 += __shfl_xor(l1, 32); l2 += __shfl_xor(l2, 32);
  const float i1 = 1.f / l1, i2 = lam / l2;
  float ss = 0.f;
#pragma unroll
  for (int blk = 0; blk < 4; ++blk)
#pragma unroll
    for (int j = 0; j < 16; ++j) { const float v = o1[blk][j] * i1 - o2[blk][j] * i2; o1[blk][j] = v; ss += v * v; }
  ss += __shfl_xor(ss, 32);
  const float rstd = rsqrtf(ss * (1.f / 128.f) + EPS) * (1.f - lam_init_of(layer));
  const float* gs = p.g_subln + layer * 128;
  u16* mix = (u16*)(ws + OFF_MIX) + (size_t)(tokbase + w * 32 + l32) * 1024 + hh * 128;
#pragma unroll
  for (int blk = 0; blk < 4; ++blk)
#pragma unroll
    for (int g4 = 0; g4 < 4; ++g4) {
      const int dv = blk * 32 + 8 * g4 + 4 * hf;
      const float4 gv = *(const float4*)(gs + dv);
      uint2 o;
      o.x = pk2(o1[blk][4 * g4] * rstd * gv.x, o1[blk][4 * g4 + 1] * rstd * gv.y);
      o.y = pk2(o1[blk][4 * g4 + 2] * rstd * gv.z, o1[blk][4 * g4 + 3] * rstd * gv.w);
      *(uint2*)(mix + dv) = o;
    }
}

template <bool FINAL, bool HORNER>
DI void ssm_unit(const P& p, int layer, int b, int blk, char* smem) {
  const int tid = get_tid(), lane = tid & 63, w = tid >> 6, fr = lane & 15, fq = lane >> 4;
  char* ws = p.ws;
  int tok0, cf, cr;
  if (blk < 256) { tok0 = b * 8192 + blk * 32; cf = 8 + blk; cr = 8 + 255 - blk; }
  else { const int cb = blk - 256; tok0 = XTOK + b * 256 + cb * 32; cf = cb; cr = 7 - cb; }
  u16* ub = (u16*)smem;
  float* BUw = (float*)(smem + 16896) + w * 16 * 132;
  __syncthreads();
  {
    const float4* src = (const float4*)((const float*)(ws + OFF_U) + (size_t)tok0 * 256);
#pragma unroll
    for (int i = 0; i < 8; ++i) {
      const int e = tid + 256 * i, row = e >> 6, c4 = (e & 63) * 4;
      const float4 v = src[e];
      uint2 o; o.x = pk2(v.x, v.y); o.y = pk2(v.z, v.w);
      *(uint2*)(ub + row * 264 + c4) = o;
    }
  }
  __syncthreads();
  const float2* AB = (const float2*)(ws + OFF_AB);
  const u16* BBH = (const u16*)(ws + OFF_BBH);
  const u16* CM = (const u16*)(ws + OFF_CM);
  float2* LOC = (float2*)(ws + OFF_LOCAL);
  const float2* CAR = (const float2*)(ws + OFF_CARRY);
  const bf16x8 zero8 = {0, 0, 0, 0, 0, 0, 0, 0};
  for (int gi = 0; gi < 4; ++gi) {
    const int g = w * 4 + gi;
    f32x4 y0 = (f32x4){0.f, 0.f, 0.f, 0.f}, y1 = (f32x4){0.f, 0.f, 0.f, 0.f};
#pragma unroll
    for (int dir = 0; dir < 2; ++dir) {
      const int sidx = ((layer * 2 + dir) * 16 + g) * 64 + lane;
      const float2 a = AB[sidx];
      const int chunk = dir ? cr : cf;
      const size_t cidx = ((size_t)((b * 2 + dir) * NCH + chunk) * 16 + g) * 64 + lane;
      float sr, si;
      if (FINAL && !HORNER) { const float2 c0 = CAR[cidx]; sr = c0.x; si = c0.y; }
      else { opaque_zero2(sr, si); }
      if (FINAL && HORNER) {
        const float2 aT = ((const float2*)(ws + OFF_AT))[sidx];
        const float2* lp = LOC + ((size_t)((b * 2 + dir) * NCH) * 16 + g) * 64 + lane;
        for (int c = 0; c < chunk; ++c) {
          const float2 lo = lp[(size_t)c * 1024];
          const float nr = aT.x * sr - aT.y * si + lo.x, ni = aT.x * si + aT.y * sr + lo.y;
          sr = nr; si = ni;
        }
      }
      const u16* bbp = BBH + ((size_t)((layer * 2 + dir) * 16 + g) * 128 + fr) * 16 + (fq & 1) * 8;
      const u16* cmp = CM + ((size_t)((layer * 2 + dir) * 16 + g) * 16 + fr) * 128 + fq * 8;
      bf16x8 bfr0 = *(const bf16x8*)(bbp), bfr1 = *(const bf16x8*)(bbp + 256), bfr2 = *(const bf16x8*)(bbp + 512), bfr3 = *(const bf16x8*)(bbp + 768);
      bf16x8 bfr4 = *(const bf16x8*)(bbp + 1024), bfr5 = *(const bf16x8*)(bbp + 1280), bfr6 = *(const bf16x8*)(bbp + 1536), bfr7 = *(const bf16x8*)(bbp + 1792);
      if (fq >= 2) { bfr0 = zero8; bfr1 = zero8; bfr2 = zero8; bfr3 = zero8; bfr4 = zero8; bfr5 = zero8; bfr6 = zero8; bfr7 = zero8; }
      bf16x8 cf0 = zero8, cf1 = zero8, cf2 = zero8, cf3 = zero8;
      if (FINAL) { cf0 = *(const bf16x8*)(cmp); cf1 = *(const bf16x8*)(cmp + 32); cf2 = *(const bf16x8*)(cmp + 64); cf3 = *(const bf16x8*)(cmp + 96); }
#pragma unroll
      for (int hh = 0; hh < 2; ++hh) {
        const int tb = dir ? 1 - hh : hh;
        {
          const bf16x8 ufl = *(const bf16x8*)(ub + (tb * 16 + fr) * 264 + g * 16 + (fq & 1) * 8);
          const bf16x8 uf = fq < 2 ? ufl : zero8;
#define BU_(CBI, BF) do { const f32x4 d = mfma16(BF, uf, (f32x4){0.f, 0.f, 0.f, 0.f}); *(f32x4*)(BUw + fr * 132 + (CBI) * 16 + fq * 4) = d; } while (0)
          BU_(0, bfr0); BU_(1, bfr1); BU_(2, bfr2); BU_(3, bfr3); BU_(4, bfr4); BU_(5, bfr5); BU_(6, bfr6); BU_(7, bfr7);
#undef BU_
        }
        __syncthreads();
#pragma unroll 4
        for (int tt = 0; tt < 16; ++tt) {
          const int tl = dir ? 15 - tt : tt;
          const float2 bu = *(const float2*)(BUw + tl * 132 + 2 * lane);
          const float nr = a.x * sr - a.y * si + bu.x, ni = a.x * si + a.y * sr + bu.y;
          sr = nr; si = ni;
          if (FINAL) { u16* srow = (u16*)(BUw + tl * 132); srow[lane] = bf1(sr); srow[64 + lane] = bf1(si); }
        }
        __syncthreads();
        if (FINAL) {
          f32x4 yy = tb == 0 ? y0 : y1;
          const u16* sp = (const u16*)(BUw + fr * 132) + fq * 8;
          yy = mfma16(cf0, *(const bf16x8*)(sp), yy);
          yy = mfma16(cf1, *(const bf16x8*)(sp + 32), yy);
          yy = mfma16(cf2, *(const bf16x8*)(sp + 64), yy);
          yy = mfma16(cf3, *(const bf16x8*)(sp + 96), yy);
          if (tb == 0) y0 = yy; else y1 = yy;
          __syncthreads();
        }
      }
      if (!FINAL) LOC[cidx] = make_float2(sr, si);
    }
    if (FINAL) {
      const int ch = g * 16 + fq * 4;
      const float4 dsk = *(const float4*)(p.ssm_d + layer * 256 + ch);
      u16* hg = (u16*)(ws + OFF_HGLU);
#pragma unroll
      for (int tb = 0; tb < 2; ++tb) {
        const int t = tb * 16 + fr;
        const f32x4 yv = tb == 0 ? y0 : y1;
        const uint2 uraw = *(const uint2*)(ub + t * 264 + ch);
        const float u0 = bf2f((u16)(uraw.x & 0xffff)), u1 = bf2f((u16)(uraw.x >> 16)), u2 = bf2f((u16)(uraw.y & 0xffff)), u3 = bf2f((u16)(uraw.y >> 16));
        const float r0 = gelu_tanh(yv[0] + dsk.x * u0), r1 = gelu_tanh(yv[1] + dsk.y * u1);
        const float r2 = gelu_tanh(yv[2] + dsk.z * u2), r3 = gelu_tanh(yv[3] + dsk.w * u3);
        uint2 o; o.x = pk2(r0, r1); o.y = pk2(r2, r3);
        *(uint2*)(hg + (size_t)(tok0 + t) * 256 + ch) = o;
      }
    }
  }
}

DI void ssm_carry_unit(const P& p, int layer, int u, char* smem) {
  const int tid = get_tid(), seg = tid >> 5, sl = tid & 31;
  const int st = u * 32 + sl;
  const int gn = st & 1023, bd = st >> 10, dir = bd & 1;
  float2* tot = (float2*)smem;
  const float2 aT = ((const float2*)(p.ws + OFF_AT))[((layer * 2 + dir) * 1024) + gn];
  const float2* LOC = (const float2*)(p.ws + OFF_LOCAL) + (size_t)bd * NCH * 1024 + gn + (size_t)seg * 33 * 1024;
  float2* CAR = (float2*)(p.ws + OFF_CARRY) + (size_t)bd * NCH * 1024 + gn + (size_t)seg * 33 * 1024;
  __syncthreads();
  float sr, si;
  opaque_zero2(sr, si);
  float pr = 1.f, pi = 0.f;
#pragma unroll 11
  for (int j = 0; j < 33; ++j) {
    const float2 lo = LOC[(size_t)j * 1024];
    const float nr = aT.x * sr - aT.y * si + lo.x, ni = aT.x * si + aT.y * sr + lo.y;
    sr = nr; si = ni;
    const float qr = pr * aT.x - pi * aT.y, qi = pr * aT.y + pi * aT.x;
    pr = qr; pi = qi;
  }
  tot[seg * 32 + sl] = make_float2(sr, si);
  __syncthreads();
  opaque_zero2(sr, si);
  for (int k = 0; k < seg; ++k) {
    const float2 t = tot[k * 32 + sl];
    const float nr = pr * sr - pi * si + t.x, ni = pr * si + pi * sr + t.y;
    sr = nr; si = ni;
  }
#pragma unroll 11
  for (int j = 0; j < 33; ++j) {
    CAR[(size_t)j * 1024] = make_float2(sr, si);
    const float2 lo = LOC[(size_t)j * 1024];
    const float nr = aT.x * sr - aT.y * si + lo.x, ni = aT.x * si + aT.y * sr + lo.y;
    sr = nr; si = ni;
  }
}

DI void fft1_unit(const P& p, int u, char* smem) {
  const int tid = get_tid(), lane = tid & 63, w = tid >> 6, fr = lane & 15, fq = lane >> 4;
  const int b = u >> 8, col = (u >> 2) & 63, g = u & 3;
  u16* Ht = (u16*)smem;
  __syncthreads();
  const float* F = (const float*)(p.ws + OFF_F);
#pragma unroll
  for (int i = 0; i < 8; ++i) {
    const int r = (tid >> 4) + 16 * i, c4 = (tid & 15) * 4;
    const float4 v = *(const float4*)(F + (size_t)(b * 8192 + 64 * r + col) * 256 + g * 64 + c4);
    Ht[(c4 + 0) * 136 + r] = bf1(v.x); Ht[(c4 + 1) * 136 + r] = bf1(v.y); Ht[(c4 + 2) * 136 + r] = bf1(v.z); Ht[(c4 + 3) * 136 + r] = bf1(v.w);
  }
  __syncthreads();
  f32x4 acc[4][4];
#pragma unroll
  for (int n = 0; n < 4; ++n)
#pragma unroll
    for (int m = 0; m < 4; ++m) acc[n][m] = (f32x4){0.f, 0.f, 0.f, 0.f};
  const u16* D = (const u16*)(p.ws + OFF_D128);
#pragma unroll
  for (int kk = 0; kk < 4; ++kk) {
    bf16x8 hfv[4], df[4];
#pragma unroll
    for (int n = 0; n < 4; ++n) hfv[n] = *(const bf16x8*)(Ht + (n * 16 + fr) * 136 + kk * 32 + fq * 8);
#pragma unroll
    for (int m = 0; m < 4; ++m) df[m] = *(const bf16x8*)(D + (size_t)(64 * w + 16 * m + fr) * 128 + kk * 32 + fq * 8);
#pragma unroll
    for (int n = 0; n < 4; ++n)
#pragma unroll
      for (int m = 0; m < 4; ++m) acc[n][m] = mfma16(hfv[n], df[m], acc[n][m]);
  }
  float* T = (float*)(p.ws + OFF_T);
#pragma unroll
  for (int m = 0; m < 4; ++m) {
    const int dr = 64 * w + 16 * m + fr, ri = dr >> 7, k1 = dr & 127;
    float* dst = T + ((size_t)(((b * 4 + g) * 128 + k1) * 2 + ri) * 64 + col) * 64;
#pragma unroll
    for (int n = 0; n < 4; ++n) *(f32x4*)(dst + n * 16 + fq * 4) = acc[n][m];
  }
}

DI void fft2_unit(const P& p, int layer, int u, char* smem) {
  const int tid = get_tid(), lane = tid & 63, w = tid >> 6, fr = lane & 15, fq = lane >> 4;
  const int b = u >> 9, k1 = (u >> 2) & 127, g = u & 3;
  u16* Xt = (u16*)smem;
  u16* Gt = Xt + 64 * 136;
  __syncthreads();
  const float* T = (const float*)(p.ws + OFF_T) + (size_t)(((b * 4 + g) * 128 + k1) * 2) * 4096;
  const float2* TW = (const float2*)(p.ws + OFF_TW) + k1 * 64;
#pragma unroll
  for (int i = 0; i < 4; ++i) {
    const int col = (tid >> 4) + 16 * i, c4 = (tid & 15) * 4;
    const float4 re = *(const float4*)(T + col * 64 + c4), im = *(const float4*)(T + 4096 + col * 64 + c4);
    const float2 tw = TW[col];
    const float rr[4] = {re.x, re.y, re.z, re.w}, ii[4] = {im.x, im.y, im.z, im.w};
#pragma unroll
    for (int e = 0; e < 4; ++e) {
      Xt[(c4 + e) * 136 + col] = bf1(rr[e] * tw.x - ii[e] * tw.y);
      Xt[(c4 + e) * 136 + 64 + col] = bf1(rr[e] * tw.y + ii[e] * tw.x);
    }
  }
  __syncthreads();
  {
    f32x4 acc[4][2];
#pragma unroll
    for (int n = 0; n < 4; ++n) { acc[n][0] = (f32x4){0.f, 0.f, 0.f, 0.f}; acc[n][1] = (f32x4){0.f, 0.f, 0.f, 0.f}; }
    const u16* D = (const u16*)(p.ws + OFF_D64);
#pragma unroll
    for (int kk = 0; kk < 4; ++kk) {
      bf16x8 xf[4], df[2];
#pragma unroll
      for (int n = 0; n < 4; ++n) xf[n] = *(const bf16x8*)(Xt + (n * 16 + fr) * 136 + kk * 32 + fq * 8);
#pragma unroll
      for (int m = 0; m < 2; ++m) df[m] = *(const bf16x8*)(D + (size_t)(32 * w + 16 * m + fr) * 128 + kk * 32 + fq * 8);
#pragma unroll
      for (int n = 0; n < 4; ++n)
#pragma unroll
        for (int m = 0; m < 2; ++m) acc[n][m] = mfma16(xf[n], df[m], acc[n][m]);
    }
#pragma unroll
    for (int m = 0; m < 2; ++m) {
      const int row2 = 32 * w + 16 * m + fr, ri = row2 >> 6, k2 = row2 & 63;
#pragma unroll
      for (int n = 0; n < 4; ++n) {
        uint2 o; o.x = pk2(acc[n][m][0], acc[n][m][1]); o.y = pk2(acc[n][m][2], acc[n][m][3]);
        *(uint2*)(Gt + k2 * 136 + ri * 64 + n * 16 + fq * 4) = o;
      }
    }
  }
  __syncthreads();
  {
    f32x4 acc[4];
#pragma unroll
    for (int n = 0; n < 4; ++n) acc[n] = (f32x4){0.f, 0.f, 0.f, 0.f};
    const u16* W = (const u16*)(p.ws + OFF_WCS) + (size_t)(layer * 4 + g) * 64 * 128;
#pragma unroll
    for (int kk = 0; kk < 4; ++kk) {
      const bf16x8 gf = *(const bf16x8*)(Gt + (16 * w + fr) * 136 + kk * 32 + fq * 8);
#pragma unroll
      for (int n = 0; n < 4; ++n) {
        const bf16x8 wf = *(const bf16x8*)(W + (size_t)(n * 16 + fr) * 128 + kk * 32 + fq * 8);
        acc[n] = mfma16(wf, gf, acc[n]);
      }
    }
    const int k2 = 16 * w + fr;
    u16* mix = (u16*)(p.ws + OFF_MIX) + (size_t)(b * 8192 + k1 + 128 * k2) * 1024 + 768 + g * 64;
#pragma unroll
    for (int n = 0; n < 4; ++n) {
      uint2 o; o.x = pk2(acc[n][0], acc[n][1]); o.y = pk2(acc[n][2], acc[n][3]);
      *(uint2*)(mix + n * 16 + fq * 4) = o;
    }
  }
}

DI void ctxfft_unit(const P& p, int layer, int u, char* smem) {
  const int tid = get_tid();
  const int b = u >> 6, g = (u >> 4) & 3, kb = u & 15;
  float2* tab = (float2*)smem;
  float* Gs = (float*)(smem + 2048);
  float* zs = Gs + 16 * 128;
  __syncthreads();
  { const float ang = 6.283185307179586f * (float)tid / 256.f; tab[tid] = make_float2(cosf(ang), sinf(ang)); }
  __syncthreads();
  const int kl = tid >> 4, c4 = (tid & 15) * 4, k = kb * 16 + kl;
  const float* F = (const float*)(p.ws + OFF_F) + (size_t)(XTOK + b * 256) * 256 + g * 64 + c4;
  float gr[4] = {0.f, 0.f, 0.f, 0.f}, gim[4] = {0.f, 0.f, 0.f, 0.f};
#pragma unroll 16
  for (int l = 0; l < 256; ++l) {
    const float4 hv = *(const float4*)(F + (size_t)l * 256);
    const float2 cs = tab[(k * l) & 255];
    gr[0] += cs.x * hv.x; gr[1] += cs.x * hv.y; gr[2] += cs.x * hv.z; gr[3] += cs.x * hv.w;
    gim[0] -= cs.y * hv.x; gim[1] -= cs.y * hv.y; gim[2] -= cs.y * hv.z; gim[3] -= cs.y * hv.w;
  }
#pragma unroll
  for (int e = 0; e < 4; ++e) { Gs[kl * 128 + c4 + e] = gr[e]; Gs[kl * 128 + 64 + c4 + e] = gim[e]; }
  __syncthreads();
  float z[4] = {0.f, 0.f, 0.f, 0.f};
  for (int c = 0; c < 64; ++c) {
    const float a = Gs[kl * 128 + c], bi = Gs[kl * 128 + 64 + c];
#pragma unroll
    for (int e = 0; e < 4; ++e) { const float2 cs = tab[((c * (c4 + e)) & 63) * 4]; z[e] += a * cs.x + bi * cs.y; }
  }
#pragma unroll
  for (int e = 0; e < 4; ++e) zs[kl * 64 + c4 + e] = z[e] * (1.f / 128.f);
  __syncthreads();
  const float* wf = p.w_fnet + (size_t)(layer * 4 + g) * 4096;
  float o[4] = {0.f, 0.f, 0.f, 0.f};
  for (int cp = 0; cp < 64; ++cp) {
    const float zv = zs[kl * 64 + cp];
    const float4 wv = *(const float4*)(wf + cp * 64 + c4);
    o[0] += zv * wv.x; o[1] += zv * wv.y; o[2] += zv * wv.z; o[3] += zv * wv.w;
  }
  u16* mix = (u16*)(p.ws + OFF_MIX) + (size_t)(XTOK + b * 256 + k) * 1024 + 768 + g * 64 + c4;
  uint2 ov; ov.x = pk2(o[0], o[1]); ov.y = pk2(o[2], o[3]);
  *(uint2*)mix = ov;
}


#define XB_TMO      128
#define XB_XCNT(j)  (256  + 64 * (j))
#define XB_XSUB(j)  (1280 + 64 * (j))
#define XB_XGEN(j)  (2304 + 64 * (j))
#define XB_TOP      3328
#define XB_TOPGEN   3392
#define XB_SPIN_CAP (1u << 18)
#define LAS __attribute__((address_space(3)))
DI unsigned xb_ld(unsigned* q) { return __hip_atomic_load(q, __ATOMIC_RELAXED, __HIP_MEMORY_SCOPE_AGENT); }
DI unsigned xb_add(unsigned* q, unsigned v) { return __hip_atomic_fetch_add(q, v, __ATOMIC_RELAXED, __HIP_MEMORY_SCOPE_AGENT); }
DI unsigned xb_xcc_id() { return (unsigned)__builtin_amdgcn_s_getreg((3 << 11) | 20) & 0xFu; }
#define XB_SPIN(cond, bar) do { unsigned _sp = 0; while (cond) { __builtin_amdgcn_s_sleep(1); \
    if ((++_sp & 255u) == 0u) { if (xb_ld(&(bar)[XB_TMO])) break; if (_sp > XB_SPIN_CAP) { atomicAdd(&(bar)[XB_TMO], 1u); break; } } } } while (0)
struct XcdBarrier { unsigned* bar; unsigned x; volatile LAS unsigned* st; };
DI XcdBarrier xcd_barrier_post(unsigned* bar, volatile LAS unsigned* st) {
  XcdBarrier b; b.bar = bar; b.x = xb_xcc_id(); b.st = st;
  if (threadIdx.x == 0) (void)xb_add(&bar[XB_XCNT(b.x)], 1u);
  return b;
}
DI void xcd_barrier_complete(unsigned* bar, unsigned x, unsigned& nloc, unsigned& nx) {
  const unsigned G = gridDim.x * gridDim.y * gridDim.z;
  unsigned sum, cnt, mine, sp = 0u;
  for (;;) {
    sum = 0u; cnt = 0u; mine = 0u;
#pragma unroll
    for (unsigned j = 0; j < 16; ++j) { const unsigned c = xb_ld(&bar[XB_XCNT(j)]); sum += c; cnt += (c > 0u) ? 1u : 0u; mine = (j == x) ? c : mine; }
    if (sum == G) break;
    __builtin_amdgcn_s_sleep(1);
    if ((++sp & 255u) == 0u) { if (xb_ld(&bar[XB_TMO])) break; if (sp > XB_SPIN_CAP) { atomicAdd(&bar[XB_TMO], 1u); break; } }
  }
  nloc = mine > 0u ? mine : 1u; nx = cnt > 0u ? cnt : 1u;
}
DI void xcd_barrier(const XcdBarrier& b) {
  asm volatile("s_waitcnt vmcnt(0)" ::: "memory");
  __syncthreads();
  if (threadIdx.x == 0) {
    unsigned* bar = b.bar;
    __builtin_amdgcn_s_waitcnt(0);
    unsigned nloc = b.st[0], nx = b.st[1];
    if (nloc == 0u) { xcd_barrier_complete(bar, b.x, nloc, nx); b.st[0] = nloc; b.st[1] = nx; }
    const unsigned old = xb_add(&bar[XB_XSUB(b.x)], 1u);
    const unsigned gen = old / nloc;
    if (old + 1u == (gen + 1u) * nloc) {
      __builtin_amdgcn_fence(__ATOMIC_RELEASE, "agent");
      asm volatile("s_waitcnt vmcnt(0)" ::: "memory");
      const unsigned og = xb_add(&bar[XB_TOP], 1u);
      const unsigned tg = og / nx;
      if (og + 1u == (tg + 1u) * nx) xb_add(&bar[XB_TOPGEN], 1u);
      else XB_SPIN(xb_ld(&bar[XB_TOPGEN]) == tg, bar);
      __builtin_amdgcn_fence(__ATOMIC_ACQUIRE, "agent");
      xb_add(&bar[XB_XGEN(b.x)], 1u);
      asm volatile("s_waitcnt vmcnt(0)" ::: "memory");
    } else {
      XB_SPIN(xb_ld(&bar[XB_XGEN(b.x)]) == gen, bar);
      __builtin_amdgcn_fence(__ATOMIC_ACQUIRE, "agent");
      asm volatile("s_waitcnt vmcnt(0)" ::: "memory");
    }
  }
  __syncthreads();
}

constexpr int NSUB = 10;
constexpr int NPHASE = 1 + DEPTH * NSUB;
DI int sub_of(int i) { return (int)((0x76d54983ba210cULL >> (4 * i)) & 15ULL); }

#define LOOPB(N, ROT, ...) do { const int n_ = (N); int br_ = B - (ROT); if (br_ < 0) br_ += G; \
    for (int u0_ = br_ & ~1; u0_ < n_; u0_ += G) { int u = u0_ + (br_ & 1); const bool dup = u >= n_; if (dup) u = n_ - 1; __VA_ARGS__; } } while (0)
#define LOOPG(N, CALL) do { const int n_ = (N); const int full_ = (n_ / G) * G; const int rem_ = n_ - full_; \
    for (int u = B; u < full_; u += G) { CALL(u, false, 0); } \
    if (rem_ > 0) { \
      if (rem_ * 2 <= G) { const int wg_ = B >> 1; if (wg_ < rem_) { CALL(full_ + wg_, false, (B & 1) + 1); } } \
      else { const int u0_ = full_ + (B & ~1); if (u0_ < n_) { int u = u0_ + (B & 1); const bool dup = u >= n_; if (dup) u = n_ - 1; CALL(u, dup, -1); } } \
    } } while (0)
#define LOOPN(N, ROT, ...) do { const int n_ = (N); int br_ = B - (ROT); if (br_ < 0) br_ += G; \
    for (int u = br_; u < n_; u += G) { __VA_ARGS__; } } while (0)

DI void run_phase(const P& p, int ph, char* smem) {
  const int G = gridDim.x * 2, B = blockIdx.x * 2 + __builtin_amdgcn_readfirstlane(threadIdx.x >> 8);
  char* ws = p.ws;
  char* smem_o = (B & 1) ? smem - LDS_BYTES : smem + LDS_BYTES;
  if (ph == 0) {
    LOOPB(11328, 0, prep_transposes(p, u, smem));
    LOOPB(384, 0, prep_mod(p, u, smem));
    LOOPN(32, 384, prep_disc(p, u));
    LOOPN(N_TABLE_UNITS, 0, prep_tables(p, u));
    LOOPN(512, 0, prep_wcs(p, u));
    LOOPN(1024, 0, prep_cm(p, u));
    return;
  }
  const int layer = (ph - 1) / NSUB, sub = (ph - 1) % NSUB;
  const bool lastl = layer == DEPTH - 1;
  const int nmt = lastl ? 128 : 132;
  switch (sub) {
    case 0: LOOPN(2112, 0, norm_unit(p, layer, 0, u)); break;
    case 1: {
      const u16* Wt = (const u16*)(ws + OFF_WIN) + (size_t)layer * 2048 * 1024;
#define CALL_(u, dup, role) gemm_unit<1, EPI_PROJ>(p, layer, (u) >> 4, (u) & 15, 1024, Wt, ws + OFF_HN, 1024, nullptr, nullptr, nullptr, smem, dup, role, smem_o)
      LOOPG(132 * 16, CALL_);
#undef CALL_
    } break;
    case 2: {
      LOOPB(512, 0, (ssm_unit<false, false>(p, layer, u >> 8, u & 255, smem)));
      LOOPB(16, 0, (ssm_unit<false, false>(p, layer, u >> 3, 256 + (u & 7), smem)));
      LOOPB(512, 0, fft1_unit(p, u, smem));
      if (!lastl) LOOPB(128, 16, ctxfft_unit(p, layer, u, smem));
    } break;
    case 3: {
      LOOPB(128, 0, ssm_carry_unit(p, layer, u, smem));
      if (!lastl) LOOPB(16, 128, (ssm_unit<true, true>(p, layer, u >> 3, 256 + (u & 7), smem)));
      if (!lastl) LOOPB(16, 144, attn_unit(p, layer, 512 + u, smem));
      LOOPB(1024, 0, fft2_unit(p, layer, u, smem));
    } break;
    case 4: {
      LOOPB(512, 0, attn_unit(p, layer, u, smem));
      LOOPB(512, 0, (ssm_unit<true, false>(p, layer, u >> 8, u & 255, smem)));
    } break;
    case 5: {
      const u16* Wt = (const u16*)(ws + OFF_WGLU) + (size_t)layer * 256 * 256;
      LOOPB(nmt * 2, 0, (gemm_unit<1, EPI_GLU>(p, layer, u >> 1, u & 1, 256, Wt, ws + OFF_HGLU, 256, nullptr, nullptr, nullptr, smem, dup)));
    } break;
    case 6: {
      const u16* Wt = (const u16*)(ws + OFF_WOUT) + (size_t)layer * 1024 * 1024;
#define CALL_(u, dup, role) gemm_unit<1, EPI_OUT>(p, layer, (u) >> 3, (u) & 7, 1024, Wt, ws + OFF_MIX, 1024, nullptr, nullptr, nullptr, smem, dup, role, smem_o)
      LOOPG(nmt * 8, CALL_);
#undef CALL_
    } break;
    case 7: LOOPN(nmt * 16, 0, norm_unit(p, layer, 1, u)); break;
    case 8: {
      const u16* Wt = (const u16*)(ws + OFF_WFF1) + (size_t)layer * 4096 * 1024;
#define CALL_(u, dup, role) gemm_unit<1, EPI_FF1>(p, layer, (u) >> 5, (u) & 31, 1024, Wt, ws + OFF_HN, 1024, nullptr, nullptr, nullptr, smem, dup, role, smem_o)
      LOOPG(nmt * 32, CALL_);
#undef CALL_
    } break;
    case 9: {
      const u16* Wt = (const u16*)(ws + OFF_WFF2) + (size_t)layer * 1024 * 4096;
#define CALL_(u, dup, role) gemm_unit<1, EPI_FF2>(p, layer, (u) >> 3, (u) & 7, 4096, Wt, ws + OFF_HID, 4096, nullptr, nullptr, nullptr, smem, dup, role, smem_o)
      LOOPG(nmt * 8, CALL_);
#undef CALL_
    } break;
  }
}

__global__ void __launch_bounds__(512) mega(P p, int ph_lo, int ph_hi, int coop) {
  __shared__ __attribute__((aligned(16))) char smem_all[2 * LDS_BYTES];
  __shared__ uint4 xb_words;
  char* smem = smem_all + __builtin_amdgcn_readfirstlane(threadIdx.x >> 8) * LDS_BYTES;
  if (threadIdx.x == 0) xb_words = make_uint4(0u, 0u, 0u, 0u);
  __syncthreads();
  XcdBarrier xb = xcd_barrier_post((unsigned*)(p.ws + OFF_BAR), (volatile LAS unsigned*)&xb_words);
  for (int ph = ph_lo; ph < ph_hi; ++ph) {
    P q = p;
    asm volatile("" : "+s"(q.ws));
    run_phase(q, ph, smem);
    if (coop && ph + 1 < ph_hi) {
      if (ph == ph_lo) {
        asm volatile("s_waitcnt vmcnt(0)" ::: "memory");
        cg::this_grid().sync();
        if (threadIdx.x < 64) {
          __builtin_amdgcn_fence(__ATOMIC_ACQUIRE, "agent");
          asm volatile("s_waitcnt vmcnt(0)" ::: "memory");
        }
        __syncthreads();
      } else {
        xcd_barrier(xb);
      }
    }
  }
}

#ifdef DBG_DUMP
__global__ void __launch_bounds__(256) dumpk(P p) {
  const size_t n = (size_t)XTOK * 1024;
  for (size_t i = (size_t)blockIdx.x * 256 + threadIdx.x; i < n; i += (size_t)gridDim.x * 256) {
#if DBG_DUMP == 0
    { const int cc = (int)(i & 1023); p.out[i] = (cc >= DBG_CLO && cc < DBG_CHI) ? bf2f(((const u16*)(p.ws + OFF_MIX))[i]) : 0.f; }
#elif DBG_DUMP == 8
    p.out[i] = i < (size_t)512 * 1024 ? bf2f(((const u16*)(p.ws + OFF_MIX))[(size_t)XTOK * 1024 + i]) : 0.f;
#elif DBG_DUMP == 9
    p.out[i] = i < (size_t)512 * 1024 ? ((const float*)(p.ws + OFF_XBUF))[(size_t)XTOK * 1024 + i] : 0.f;
#elif DBG_DUMP == 10
    p.out[i] = ((const float*)(p.ws + OFF_T))[i % ((size_t)8388608)];
#elif DBG_DUMP == 11
    p.out[i] = bf2f(((const u16*)(p.ws + OFF_WIN))[(size_t)3 * 2048 * 1024 + (i % ((size_t)2048 * 1024))]);
#elif DBG_DUMP == 13
    p.out[i] = bf2f(((const u16*)(p.ws + OFF_WIN))[(size_t)3 * 2048 * 1024 + (i % ((size_t)2048 * 1024))]) + ((const float*)(p.ws + OFF_MOD))[i % ((size_t)4 * 3 * 6144)];
#elif DBG_DUMP == 12
    p.out[i] = ((const float*)(p.ws + OFF_MOD))[i % ((size_t)4 * 3 * 6144)];
#elif DBG_DUMP == 1
    p.out[i] = ((const float*)(p.ws + OFF_XBUF))[i];
#elif DBG_DUMP == 2
    p.out[i] = bf2f(((const u16*)(p.ws + OFF_Q))[i % ((size_t)2*4*2*8192*64)]) + bf2f(((const u16*)(p.ws + OFF_K))[i % ((size_t)2*4*2*8448*64)]) + bf2f(((const u16*)(p.ws + OFF_VT))[i % ((size_t)2*4*8448*128)]);
#elif DBG_DUMP == 3
    p.out[i] = ((const float*)(p.ws + OFF_U))[i % ((size_t)NTOK*256)] + ((const float*)(p.ws + OFF_F))[i % ((size_t)NTOK*256)];
#elif DBG_DUMP == 4
    p.out[i] = bf2f(((const u16*)(p.ws + OFF_HGLU))[i % ((size_t)NTOK*256)]);
#endif
  }
}
#endif

extern "C" void kernel_launch(void* const* d_in, const int* in_sizes, int n_in, void* d_out, int out_size, void* d_ws, size_t ws_size,
                              hipStream_t stream) {
  static int grid_blocks = 0;
  if (!grid_blocks) {
    int dev = 0, cus = 0, per_cu = 0;
    hipGetDevice(&dev);
    hipDeviceGetAttribute(&cus, hipDeviceAttributeMultiprocessorCount, dev);
    hipOccupancyMaxActiveBlocksPerMultiprocessor(&per_cu, mega, 512, 0);
    if (per_cu < 1) per_cu = 1;
    if (per_cu > 1) per_cu = 1;
    grid_blocks = cus * per_cu;
  }
  if (ws_size < WS_NEED) { fprintf(stderr, "workspace too small: %zu < %zu\n", ws_size, (size_t)WS_NEED); return; }
  P p{};
  const float** pp = (const float**)&p;
  for (int i = 0; i < 30; ++i) pp[i] = (const float*)d_in[i];
  p.out = (float*)d_out;
  p.ws = (char*)d_ws;
#ifdef DBG_MEMSET
  hipMemsetAsync(d_ws, 0, WS_NEED, stream);
#endif
  hipMemsetAsync((char*)d_ws + OFF_BAR, 0, BAR_BYTES, stream);
#if COOP
#ifdef DBG_STOP
  int lo = 0, hi = DBG_STOP, coop = 1;
#else
  int lo = 0, hi = NPHASE, coop = 1;
#endif
  void* args[] = {&p, &lo, &hi, &coop};
  hipError_t e = hipLaunchCooperativeKernel((void*)mega, dim3(grid_blocks), dim3(512), args, 0, stream);
  if (e != hipSuccess) fprintf(stderr, "cooperative launch failed: %s (grid %d)\n", hipGetErrorString(e), grid_blocks);
#ifdef DBG_DUMP
  dumpk<<<dim3(1024), dim3(256), 0, stream>>>(p);
#endif
#else
#ifdef DBG_STOP
  for (int ph = 0; ph < DBG_STOP; ++ph) mega<<<dim3(grid_blocks), dim3(512), 0, stream>>>(p, ph, ph + 1, 0);
#else
  for (int ph = 0; ph < NPHASE; ++ph) mega<<<dim3(grid_blocks), dim3(512), 0, stream>>>(p, ph, ph + 1, 0);
#endif
#ifdef DBG_DUMP
  dumpk<<<dim3(1024), dim3(256), 0, stream>>>(p);
#endif
#endif
}
```

```cpp
#include <hip/hip_runtime.h>
#include <hip/hip_cooperative_groups.h>
#include <cstdio>
#include <cstdint>
namespace cg = cooperative_groups;

#ifndef COOP
#define COOP 1
#endif

#define DI __device__ __forceinline__
typedef unsigned short u16;
typedef short bf16x8 __attribute__((ext_vector_type(8)));
typedef float f32x4 __attribute__((ext_vector_type(4)));
typedef float f32x16 __attribute__((ext_vector_type(16)));
typedef __bf16 bf16v2 __attribute__((ext_vector_type(2)));
typedef float f32v2 __attribute__((ext_vector_type(2)));

constexpr int DM = 1024, NBATCH = 2, SEQ = 8192, DEPTH = 4, CTX = 256;
constexpr int XTOK = NBATCH * SEQ;
constexpr int NTOK = XTOK + NBATCH * CTX;
constexpr int LK = CTX + SEQ;
constexpr int NKT = LK / 32;
constexpr int NCH = LK / 32;
constexpr int DFF = 4096;
constexpr int LDS_BYTES = 77824;
constexpr float EPS = 1e-6f;
constexpr float LOG2E = 1.4426950408889634f;

constexpr size_t AL(size_t x) { return (x + 255) & ~(size_t)255; }
constexpr size_t OFF_WIN = 0;
constexpr size_t OFF_WOUT = OFF_WIN + AL((size_t)DEPTH * 2048 * 1024 * 2);
constexpr size_t OFF_WFF1 = OFF_WOUT + AL((size_t)DEPTH * 1024 * 1024 * 2);
constexpr size_t OFF_WFF2 = OFF_WFF1 + AL((size_t)DEPTH * 4096 * 1024 * 2);
constexpr size_t OFF_WGLU = OFF_WFF2 + AL((size_t)DEPTH * 4096 * 1024 * 2);
constexpr size_t OFF_XBUF = OFF_WGLU + AL((size_t)DEPTH * 256 * 256 * 2);
constexpr size_t OFF_MIX = OFF_XBUF + AL((size_t)NTOK * 1024 * 4);
constexpr size_t OFF_MOD = OFF_MIX + AL((size_t)NTOK * 1024 * 2);
constexpr size_t OFF_SMALL = OFF_MOD + AL((size_t)DEPTH * 3 * 6144 * 4);
constexpr size_t OFF_AB = OFF_SMALL + 256;
constexpr size_t OFF_AT = OFF_AB + AL((size_t)DEPTH * 2 * 16 * 64 * 2 * 4);
constexpr size_t OFF_BBAR = OFF_AT + AL((size_t)DEPTH * 2 * 16 * 64 * 2 * 4);
constexpr size_t OFF_CM = OFF_BBAR + AL((size_t)DEPTH * 2 * 16 * 64 * 32 * 4);
constexpr size_t OFF_ROPE = OFF_CM + AL((size_t)DEPTH * 2 * 16 * 16 * 128 * 2);
constexpr size_t OFF_D128 = OFF_ROPE + AL((size_t)192 * 16 * 8);
constexpr size_t OFF_D64 = OFF_D128 + AL((size_t)256 * 128 * 2);
constexpr size_t OFF_TW = OFF_D64 + AL((size_t)128 * 128 * 2);
constexpr size_t OFF_WCS = OFF_TW + AL((size_t)128 * 64 * 8);
constexpr size_t OFF_R1 = OFF_WCS + AL((size_t)DEPTH * 4 * 64 * 128 * 2);
constexpr size_t OFF_HID = OFF_R1;
constexpr size_t OFF_Q = OFF_R1;
constexpr size_t OFF_QC = OFF_Q + AL((size_t)2 * 4 * 2 * 8192 * 64 * 2);
constexpr size_t OFF_K = OFF_QC + AL((size_t)2 * 4 * 2 * 256 * 64 * 2);
constexpr size_t OFF_VT = OFF_K + AL((size_t)2 * 4 * 2 * LK * 64 * 2);
constexpr size_t OFF_U = OFF_VT + AL((size_t)2 * 4 * LK * 128 * 2);
constexpr size_t OFF_F = OFF_U + AL((size_t)NTOK * 256 * 4);
constexpr size_t OFF_LOCAL = OFF_F + AL((size_t)NTOK * 256 * 4);
constexpr size_t OFF_CARRY = OFF_LOCAL + AL((size_t)2 * 2 * NCH * 1024 * 8);
constexpr size_t OFF_T = OFF_CARRY + AL((size_t)2 * 2 * NCH * 1024 * 8);
constexpr size_t OFF_HGLU = OFF_T + AL((size_t)2 * 4 * 128 * 2 * 64 * 64 * 4);
constexpr size_t OFF_END_MIX = OFF_HGLU + AL((size_t)NTOK * 256 * 2);
constexpr size_t OFF_END_HID = OFF_HID + AL((size_t)NTOK * 4096 * 2);
constexpr size_t OFF_XCTX2 = OFF_END_MIX > OFF_END_HID ? OFF_END_MIX : OFF_END_HID;
constexpr size_t OFF_HN = OFF_XCTX2 + AL((size_t)NBATCH * CTX * 1024 * 4);
constexpr size_t OFF_BAR = OFF_HN + AL((size_t)NTOK * 1024 * 2);
constexpr size_t BAR_BYTES = 3456 * 4;
constexpr size_t OFF_BBH = OFF_BAR + AL(BAR_BYTES);
constexpr size_t WS_NEED = OFF_BBH + AL((size_t)DEPTH * 2 * 16 * 128 * 16 * 2);

struct P {
  const float *x, *c, *ctx, *c_ctx, *w_mod, *b_mod, *g_norm1, *w_in, *g_qnorm, *g_knorm, *lam_q1, *lam_k1, *lam_q2, *lam_k2,
      *g_subln, *ssm_a_re, *ssm_a_im, *ssm_log_dt, *ssm_b_re, *ssm_b_im, *ssm_c_re, *ssm_c_im, *ssm_d, *w_glu, *b_glu, *w_fnet,
      *w_out, *g_norm2, *w_ff1, *w_ff2;
  float* out;
  char* ws;
};

DI unsigned pk2(float a, float b) { f32v2 v = {a, b}; return __builtin_bit_cast(unsigned, __builtin_convertvector(v, bf16v2)); }
DI u16 bf1(float a) { return (u16)(pk2(a, 0.f) & 0xffffu); }
DI float bf2f(u16 h) { return __uint_as_float(((unsigned)h) << 16); }
DI f32x4 mfma16(bf16x8 a, bf16x8 b, f32x4 c) { return __builtin_amdgcn_mfma_f32_16x16x32_bf16(a, b, c, 0, 0, 0); }
DI f32x16 mfma32(bf16x8 a, bf16x8 b, f32x16 c) { return __builtin_amdgcn_mfma_f32_32x32x16_bf16(a, b, c, 0, 0, 0); }
DI float silu(float v) { return v / (1.f + __expf(-v)); }
DI float gelu_tanh(float v) { float t = 0.7978845608028654f * (v + 0.044715f * v * v * v); return 0.5f * v * (1.f + tanhf(t)); }
DI int get_tid() { int t = threadIdx.x & 255; asm volatile("" : "+v"(t)); return t; }
DI void opaque_zero2(float& a, float& b) { asm volatile("v_mov_b32 %0, 0\n\tv_mov_b32 %1, 0" : "=v"(a), "=v"(b)); }
DI float* xa_tile(const P& p, int mt) { return (float*)(p.ws + OFF_XBUF) + (size_t)mt * 128 * 1024; }
DI const float* xa_rd_tile(const P& p, int layer, int mt) {
  if (layer == 0) return mt < 128 ? p.x + (size_t)mt * 128 * 1024 : p.ctx + (size_t)(mt - 128) * 128 * 1024;
  return (const float*)(p.ws + OFF_XBUF) + (size_t)mt * 128 * 1024;
}
DI float* xb_tile(const P& p, int mt) { return mt < 128 ? p.out + (size_t)mt * 128 * 1024 : (float*)(p.ws + OFF_XCTX2) + (size_t)(mt - 128) * 128 * 1024; }
DI float lam_init_of(int layer) { return 0.8f - 0.6f * expf(-0.3f * (float)layer); }

DI void tr_unit(const float* __restrict__ src, u16* __restrict__ dst, int K, int N, int u, char* smem) {
  float* t = (float*)smem;
  const int tid = get_tid();
  const int tnN = N / 64, tk = u / tnN, tn = u % tnN;
  __syncthreads();
#pragma unroll
  for (int i = 0; i < 4; ++i) {
    const int k = (tid >> 4) + 16 * i, n4 = (tid & 15) * 4;
    *(float4*)(t + k * 68 + n4) = *(const float4*)(src + (size_t)(tk * 64 + k) * N + tn * 64 + n4);
  }
  __syncthreads();
#pragma unroll
  for (int i = 0; i < 2; ++i) {
    const int item = tid + 256 * i, n = item >> 3, kb = (item & 7) * 8;
    const float* tp = t + kb * 68 + n;
    uint4 o;
    o.x = pk2(tp[0], tp[68]); o.y = pk2(tp[2 * 68], tp[3 * 68]); o.z = pk2(tp[4 * 68], tp[5 * 68]); o.w = pk2(tp[6 * 68], tp[7 * 68]);
    *(uint4*)(dst + (size_t)(tn * 64 + n) * K + tk * 64 + kb) = o;
  }
}

DI void prep_transposes(const P& p, int u, char* smem) {
  const int l = u / 2832; int r = u % 2832;
  char* ws = p.ws;
  if (r < 512) { tr_unit(p.w_in + (size_t)l * 1024 * 2048, (u16*)(ws + OFF_WIN) + (size_t)l * 2048 * 1024, 1024, 2048, r, smem); return; }
  r -= 512;
  if (r < 256) { tr_unit(p.w_out + (size_t)l * 1024 * 1024, (u16*)(ws + OFF_WOUT) + (size_t)l * 1024 * 1024, 1024, 1024, r, smem); return; }
  r -= 256;
  if (r < 1024) { tr_unit(p.w_ff1 + (size_t)l * 1024 * 4096, (u16*)(ws + OFF_WFF1) + (size_t)l * 4096 * 1024, 1024, 4096, r, smem); return; }
  r -= 1024;
  if (r < 1024) { tr_unit(p.w_ff2 + (size_t)l * 4096 * 1024, (u16*)(ws + OFF_WFF2) + (size_t)l * 1024 * 4096, 4096, 1024, r, smem); return; }
  r -= 1024;
  tr_unit(p.w_glu + (size_t)l * 256 * 256, (u16*)(ws + OFF_WGLU) + (size_t)l * 256 * 256, 256, 256, r, smem);
}

DI void prep_copy(const P& p, int u) {
  float4* dst = (float4*)(p.ws + OFF_XBUF);
  const float4* sx = (const float4*)p.x; const float4* sc = (const float4*)p.ctx;
  const size_t nx4 = (size_t)XTOK * 256;
const int tid = get_tid();
#pragma unroll 4
  for (int i = 0; i < 16; ++i) {
    const size_t idx = (size_t)u * 4096 + i * 256 + tid;
    dst[idx] = idx < nx4 ? sx[idx] : sc[idx - nx4];
  }
}

DI void prep_mod(const P& p, int u, char* smem) {
  float* act = (float*)smem;
  float* red = act + 3072;
  const int tid = get_tid();
  const int l = u / 96, jb = u % 96;
  __syncthreads();
  for (int i = tid; i < 3072; i += 256) {
    const int r = i >> 10, k = i & 1023;
    const float v = r < 2 ? p.c[r * 1024 + k] : p.c_ctx[k];
    act[i] = silu(v);
  }
  __syncthreads();
  const int j = jb * 64 + (tid & 63), kg = tid >> 6;
  float a0 = 0.f, a1 = 0.f, a2 = 0.f;
  const float* wp = p.w_mod + (size_t)l * 1024 * 6144 + j;
#pragma unroll 32
  for (int k = kg * 256; k < kg * 256 + 256; ++k) {
    const float wv = wp[(size_t)k * 6144];
    a0 += act[k] * wv; a1 += act[1024 + k] * wv; a2 += act[2048 + k] * wv;
  }
  red[(kg * 3 + 0) * 64 + (tid & 63)] = a0; red[(kg * 3 + 1) * 64 + (tid & 63)] = a1; red[(kg * 3 + 2) * 64 + (tid & 63)] = a2;
  __syncthreads();
  if (tid < 192) {
    const int r = tid >> 6, jj = tid & 63;
    float s = p.b_mod[l * 6144 + jb * 64 + jj];
    for (int q = 0; q < 4; ++q) s += red[(q * 3 + r) * 64 + jj];
    ((float*)(p.ws + OFF_MOD))[((size_t)l * 3 + r) * 6144 + jb * 64 + jj] = s;
  }
}

DI void prep_disc(const P& p, int u) {
  const int idx = u * 256 + get_tid();
  const int g = (idx >> 6) & 15;
  const int ld = idx >> 10;
  const float are = p.ssm_a_re[idx], aim = p.ssm_a_im[idx];
  const float dt = expf(p.ssm_log_dt[ld * 16 + g]);
  const float mag = expf(dt * are);
  const float abr = mag * cosf(dt * aim), abi = mag * sinf(dt * aim);
  const float den = are * are + aim * aim, nre = abr - 1.f;
  const float fre = (nre * are + abi * aim) / den, fim = (abi * are - nre * aim) / den;
  float2* AB = (float2*)(p.ws + OFF_AB); float2* AT = (float2*)(p.ws + OFF_AT);
  AB[idx] = make_float2(abr, abi);
  float tr = abr, ti = abi;
#pragma unroll
  for (int i = 0; i < 5; ++i) { const float nr = tr * tr - ti * ti, ni = 2.f * tr * ti; tr = nr; ti = ni; }
  AT[idx] = make_float2(tr, ti);
  float* bb = (float*)(p.ws + OFF_BBAR) + (size_t)idx * 32;
  const float* bre = p.ssm_b_re + (size_t)idx * 16; const float* bim = p.ssm_b_im + (size_t)idx * 16;
  for (int q = 0; q < 16; ++q) {
    const float br = bre[q], bi = bim[q];
    bb[q] = fre * br - fim * bi; bb[16 + q] = fre * bi + fim * br;
    u16* bh = (u16*)(p.ws + OFF_BBH) + ((size_t)(ld * 16 + g) * 128 + 2 * (idx & 63)) * 16;
    bh[q] = bf1(fre * br - fim * bi); bh[16 + q] = bf1(fre * bi + fim * br);
  }
}

DI void prep_tables(const P& p, int u) {
  const int i = u * 256 + get_tid();
  const float TWO_PI = 6.283185307179586f;
  char* ws = p.ws;
  if (i < 3072) {
    const int pos = i >> 4, j = i & 15;
    const float inv = powf(10000.f, -(float)j / 16.f);
    const float ang = (float)(pos < 128 ? pos : pos - 128) * inv;
    ((float2*)(ws + OFF_ROPE))[i] = make_float2(cosf(ang), sinf(ang));
    return;
  }
  int r = i - 3072;
  if (r < 32768) {
    const int row = r >> 7, rr = r & 127, ri = row >> 7, k1 = row & 127;
    const float ang = TWO_PI * (float)((k1 * rr) & 127) / 128.f;
    ((u16*)(ws + OFF_D128))[r] = bf1(ri == 0 ? cosf(ang) : -sinf(ang));
    return;
  }
  r -= 32768;
  if (r < 16384) {
    const int row = r >> 7, kx = r & 127, ri = row >> 6, k2 = row & 63, xri = kx >> 6, col = kx & 63;
    const float ang = TWO_PI * (float)((k2 * col) & 63) / 64.f;
    const float cr = cosf(ang), sr = sinf(ang);
    const float v = ri == 0 ? (xri == 0 ? cr : sr) : (xri == 0 ? -sr : cr);
    ((u16*)(ws + OFF_D64))[r] = bf1(v);
    return;
  }
  r -= 16384;
  if (r < 8192) {
    const int k1 = r >> 6, col = r & 63;
    const float ang = TWO_PI * (float)(k1 * col) / 8192.f;
    ((float2*)(ws + OFF_TW))[r] = make_float2(cosf(ang), -sinf(ang));
    return;
  }
  r -= 8192;
  if (r < DEPTH) {
    const int l = r;
    float s1 = 0.f, s2 = 0.f, gq = 0.f, gk = 0.f;
    for (int q = 0; q < 64; ++q) {
      s1 += p.lam_q1[l * 64 + q] * p.lam_k1[l * 64 + q]; s2 += p.lam_q2[l * 64 + q] * p.lam_k2[l * 64 + q];
      gq = fmaxf(gq, fabsf(p.g_qnorm[l * 64 + q])); gk = fmaxf(gk, fabsf(p.g_knorm[l * 64 + q]));
    }
    float* sm = (float*)(ws + OFF_SMALL);
    sm[l] = expf(s1) - expf(s2) + lam_init_of(l);
    sm[4 + l] = 8.f * gq * gk * LOG2E;
  }
}
constexpr int N_TABLE_UNITS = (3072 + 32768 + 16384 + 8192 + DEPTH + 255) / 256;

DI void prep_wcs(const P& p, int u) {
  const int idx = u * 256 + get_tid();
  const int k = idx & 127, d = (idx >> 7) & 63, lg = idx >> 13;
  const int ri = k >> 6, c = k & 63;
  const float* wf = p.w_fnet + (size_t)lg * 4096;
  float s = 0.f;
  for (int cp = 0; cp < 64; ++cp) {
    const float ang = 6.283185307179586f * (float)((c * cp) & 63) / 64.f;
    s += (ri == 0 ? cosf(ang) : sinf(ang)) * wf[cp * 64 + d];
  }
  ((u16*)(p.ws + OFF_WCS))[idx] = bf1(s * (1.f / 724.0773439350247f));
}

DI void prep_cm(const P& p, int u) {
  const int idx = u * 256 + get_tid();
  const int k = idx & 127, row = idx >> 7;
  const float v = k < 64 ? p.ssm_c_re[(size_t)row * 64 + k] : -p.ssm_c_im[(size_t)row * 64 + (k - 64)];
  ((u16*)(p.ws + OFF_CM))[idx] = bf1(v);
}


DI void norm_unit(const P& p, int layer, int which, int u) {
  const int tid = get_tid(), lane = tid & 63;
  const int r = u * 8 + (tid >> 6);
  const int mt = r >> 7;
  const float* xrow = (which == 0 ? xa_rd_tile(p, layer, mt) : (const float*)xb_tile(p, mt)) + (size_t)(r & 127) * 1024 + lane * 4;
  const float* modl = (const float*)(p.ws + OFF_MOD) + ((size_t)layer * 3 + (r < XTOK ? (r >> 13) : 2)) * 6144 + lane * 4;
  const float* sh = modl + (which == 0 ? 0 : 3072);
  const float* sc = modl + (which == 0 ? 1024 : 4096);
  const float* gn = (which == 0 ? p.g_norm1 : p.g_norm2) + layer * 1024 + lane * 4;
  const float4 v0 = *(const float4*)(xrow), v1 = *(const float4*)(xrow + 256), v2 = *(const float4*)(xrow + 512), v3 = *(const float4*)(xrow + 768);
  const float4 w0 = *(const float4*)(xrow + 4096), w1 = *(const float4*)(xrow + 4096 + 256), w2 = *(const float4*)(xrow + 4096 + 512), w3 = *(const float4*)(xrow + 4096 + 768);
  float4 g0 = *(const float4*)(gn), g1 = *(const float4*)(gn + 256), g2 = *(const float4*)(gn + 512), g3 = *(const float4*)(gn + 768);
  const float4 s0 = *(const float4*)(sc), s1 = *(const float4*)(sc + 256), s2 = *(const float4*)(sc + 512), s3 = *(const float4*)(sc + 768);
  const float4 h0 = *(const float4*)(sh), h1 = *(const float4*)(sh + 256), h2 = *(const float4*)(sh + 512), h3 = *(const float4*)(sh + 768);
#define SSQ4(V) (V.x * V.x + V.y * V.y + V.z * V.z + V.w * V.w)
  float ssa = SSQ4(v0) + SSQ4(v1) + SSQ4(v2) + SSQ4(v3), ssb = SSQ4(w0) + SSQ4(w1) + SSQ4(w2) + SSQ4(w3);
#undef SSQ4
#pragma unroll
  for (int o = 1; o < 64; o <<= 1) { ssa += __shfl_xor(ssa, o); ssb += __shfl_xor(ssb, o); }
  const float ra = rsqrtf(ssa * (1.f / 1024.f) + EPS), rb = rsqrtf(ssb * (1.f / 1024.f) + EPS);
  g0.x *= 1.f + s0.x; g0.y *= 1.f + s0.y; g0.z *= 1.f + s0.z; g0.w *= 1.f + s0.w;
  g1.x *= 1.f + s1.x; g1.y *= 1.f + s1.y; g1.z *= 1.f + s1.z; g1.w *= 1.f + s1.w;
  g2.x *= 1.f + s2.x; g2.y *= 1.f + s2.y; g2.z *= 1.f + s2.z; g2.w *= 1.f + s2.w;
  g3.x *= 1.f + s3.x; g3.y *= 1.f + s3.y; g3.z *= 1.f + s3.z; g3.w *= 1.f + s3.w;
  u16* dst = (u16*)(p.ws + OFF_HN) + (size_t)r * 1024 + lane * 4;
#define NORM_ST(V, RS, Gv, Hv, OFS) do { uint2 o; \
    o.x = pk2(V.x * RS * Gv.x + Hv.x, V.y * RS * Gv.y + Hv.y); \
    o.y = pk2(V.z * RS * Gv.z + Hv.z, V.w * RS * Gv.w + Hv.w); \
    *(uint2*)(dst + (OFS)) = o; } while (0)
  NORM_ST(v0, ra, g0, h0, 0); NORM_ST(v1, ra, g1, h1, 256); NORM_ST(v2, ra, g2, h2, 512); NORM_ST(v3, ra, g3, h3, 768);
  NORM_ST(w0, rb, g0, h0, 4096); NORM_ST(w1, rb, g1, h1, 4096 + 256); NORM_ST(w2, rb, g2, h2, 4096 + 512); NORM_ST(w3, rb, g3, h3, 4096 + 768);
#undef NORM_ST
}

enum { EPI_PROJ = 0, EPI_OUT = 1, EPI_FF1 = 2, EPI_FF2 = 3, EPI_GLU = 4 };
constexpr int LDT = 72;

template <int AMODE, int EPI>
DI void gemm_unit(const P& p, int layer, int mt, int nt, int K, const u16* __restrict__ Wt, const void* __restrict__ Asrc, int lda,
                  const float* gn, const float* sc, const float* sh, char* smem, bool dup, int role = -1, char* smem_other = nullptr) {
  const int tid = get_tid(), lane = tid & 63, w = tid >> 6, wr = w >> 1, wc = w & 1, fr = lane & 15, fq = lane >> 4;
  u16* As = (u16*)smem;
  u16* Bs = As + 2 * 128 * LDT;
  float* rs = (float*)(Bs + 2 * 128 * LDT);
  const int rmod = mt < 128 ? (mt >> 6) : 2;
  const float* modl = (const float*)(p.ws + OFF_MOD) + ((size_t)layer * 3 + rmod) * 6144;
  __syncthreads();
  f32x4 acc[4][4];
#pragma unroll
  for (int m = 0; m < 4; ++m)
#pragma unroll
    for (int n = 0; n < 4; ++n) acc[m][n] = (f32x4){0.f, 0.f, 0.f, 0.f};

  uint4 p0, p1, p2, p3, q0, q1, q2, q3;
  uint4 r0, r1, r2, r3, t0, t1, t2, t3;
  uint4 x0, x1, x2, x3, z0, z1, z2, z3;
  const int nk = role > 0 ? K / 128 : K / 64;
  const int kofs = role == 2 ? K / 2 : 0;
  const bool share = role == 0;
  const bool hi = share && smem_other < smem;
  const u16* Ag = (const u16*)Asrc + (size_t)(mt * 128 + (share && hi ? 64 : 0) + (tid >> 3)) * lda + (tid & 7) * 8 + kofs;
  const u16* afb = share ? ((wr == (hi ? 1 : 0)) ? As : (const u16*)smem_other) : As + wr * 64 * LDT;
  const u16* Bg = Wt + (size_t)(nt * 128 + (tid >> 3)) * K + (tid & 7) * 8 + kofs;
  const int lrow = ((tid >> 3)) * LDT + (tid & 7) * 8;
#define GLOAD(A0, A1, A2, A3, B0, B1, B2, B3, kt)                                                 \
  do {                                                                                            \
    B0 = *(const uint4*)(Bg + (kt) * 64); B1 = *(const uint4*)(Bg + (size_t)32 * K + (kt) * 64);  \
    B2 = *(const uint4*)(Bg + (size_t)64 * K + (kt) * 64); B3 = *(const uint4*)(Bg + (size_t)96 * K + (kt) * 64); \
    A0 = *(const uint4*)(Ag + (kt) * 64); A1 = *(const uint4*)(Ag + (size_t)32 * lda + (kt) * 64); \
    if (!share) { A2 = *(const uint4*)(Ag + (size_t)64 * lda + (kt) * 64); A3 = *(const uint4*)(Ag + (size_t)96 * lda + (kt) * 64); } \
  } while (0)
#define LSTORE(A0, A1, A2, A3, B0, B1, B2, B3, buf)                                               \
  do {                                                                                            \
    u16* bs_ = Bs + (buf) * 128 * LDT + lrow; u16* as_ = As + (buf) * 128 * LDT + lrow;          \
    *(uint4*)(bs_) = B0; *(uint4*)(bs_ + 32 * LDT) = B1; *(uint4*)(bs_ + 64 * LDT) = B2; *(uint4*)(bs_ + 96 * LDT) = B3; \
    *(uint4*)(as_) = A0; *(uint4*)(as_ + 32 * LDT) = A1; if (!share) { *(uint4*)(as_ + 64 * LDT) = A2; *(uint4*)(as_ + 96 * LDT) = A3; } \
  } while (0)
#define ST0 p0, p1, p2, p3, q0, q1, q2, q3
#define ST1 r0, r1, r2, r3, t0, t1, t2, t3
#define ST2 x0, x1, x2, x3, z0, z1, z2, z3
#define GLOAD_(...) GLOAD(__VA_ARGS__)
#define LSTORE_(...) LSTORE(__VA_ARGS__)
#define COMPUTE(buf)                                                                              \
  do {                                                                                            \
    _Pragma("unroll") for (int kk = 0; kk < 2; ++kk) {                                            \
      bf16x8 af[4], wf[4];                                                                        \
      _Pragma("unroll") for (int m = 0; m < 4; ++m) af[m] = *(const bf16x8*)(afb + (buf) * 128 * LDT + (m * 16 + fr) * LDT + kk * 32 + fq * 8); \
      _Pragma("unroll") for (int n = 0; n < 4; ++n) wf[n] = *(const bf16x8*)(Bs + (buf) * 128 * LDT + (wc * 64 + n * 16 + fr) * LDT + kk * 32 + fq * 8); \
      _Pragma("unroll") for (int m = 0; m < 4; ++m)                                               \
        _Pragma("unroll") for (int n = 0; n < 4; ++n) acc[m][n] = mfma16(wf[n], af[m], acc[m][n]); \
    }                                                                                             \
  } while (0)

#define STEP(SL, SS, buf, i)                                          \
  if (kt + (i) < nk) {                                                \
    if (kt + (i) + 3 < nk) GLOAD_(SL, kt + (i) + 3);                  \
    COMPUTE(buf);                                                     \
    if (kt + (i) + 1 < nk) LSTORE_(SS, (buf) ^ 1);                    \
    __syncthreads();                                                  \
  }
  GLOAD_(ST0, 0);
  GLOAD_(ST1, 1);
  if (nk > 2) GLOAD_(ST2, 2);
  LSTORE_(ST0, 0);
  __syncthreads();
  for (int kt = 0; kt < nk; kt += 6) {
    STEP(ST0, ST1, 0, 0)
    STEP(ST1, ST2, 1, 1)
    STEP(ST2, ST0, 0, 2)
    STEP(ST0, ST1, 1, 3)
    STEP(ST1, ST2, 0, 4)
    STEP(ST2, ST0, 1, 5)
  }
#undef STEP
#undef GLOAD
#undef LSTORE
#undef COMPUTE
#undef ST0
#undef ST1
#undef ST2
#undef GLOAD_
#undef LSTORE_
  if (role > 0) {
    if (role == 2) {
#pragma unroll
      for (int m = 0; m < 4; ++m)
#pragma unroll
        for (int n = 0; n < 4; ++n) *(f32x4*)(smem + ((size_t)((m * 4 + n) * 256 + tid)) * 16) = acc[m][n];
    }
    __syncthreads();
    if (role == 2) return;
#pragma unroll
    for (int m = 0; m < 4; ++m)
#pragma unroll
      for (int n = 0; n < 4; ++n) acc[m][n] = acc[m][n] + *(const f32x4*)(smem_other + ((size_t)((m * 4 + n) * 256 + tid)) * 16);
  }

  if (dup) return;
  const int tok0 = mt * 128 + wr * 64 + fr;
  const int f0 = nt * 128 + wc * 64 + fq * 4;
  char* ws = p.ws;
  if (EPI == EPI_PROJ) {
    const bool isctx = mt >= 128;
    if (nt < 8) {
      const int grp = nt * 2 + wc; const bool isK = grp >= 8; const int gi = grp & 7, hh = gi >> 1, mp = gi & 1;
      const float* gw = (isK ? p.g_knorm : p.g_qnorm) + layer * 64;
      float gwv[4][4];
#pragma unroll
      for (int n = 0; n < 4; ++n) { const float4 t = *(const float4*)(gw + n * 16 + fq * 4); gwv[n][0] = t.x; gwv[n][1] = t.y; gwv[n][2] = t.z; gwv[n][3] = t.w; }
      const float2* rope = (const float2*)(ws + OFF_ROPE);
      const float osc = isK ? 1.f : 0.125f * LOG2E;
#pragma unroll
      for (int m = 0; m < 4; ++m) {
        const int tok = tok0 + m * 16;
        float ss = 0.f;
#pragma unroll
        for (int n = 0; n < 4; ++n)
#pragma unroll
          for (int j = 0; j < 4; ++j) ss += acc[m][n][j] * acc[m][n][j];
        ss += __shfl_xor(ss, 16); ss += __shfl_xor(ss, 32);
        const float rstd = rsqrtf(ss * (1.f / 64.f) + EPS);
        float v[4][4];
#pragma unroll
        for (int n = 0; n < 4; ++n)
#pragma unroll
          for (int j = 0; j < 4; ++j) v[n][j] = acc[m][n][j] * rstd * gwv[n][j];
        u16* dst;
        if (!isctx) {
          const int b = tok >> 13, t = tok & 8191, prow = t >> 6, pcol = t & 63;
#pragma unroll
          for (int n = 0; n < 2; ++n) {
            const float2* rp = rope + (size_t)(n == 0 ? prow : 128 + pcol) * 16 + fq * 4;
#pragma unroll
            for (int j = 0; j < 4; ++j) {
              const float2 cs = rp[j];
              const float x1 = v[n][j], x2 = v[n + 2][j];
              v[n][j] = x1 * cs.x - x2 * cs.y; v[n + 2][j] = x2 * cs.x + x1 * cs.y;
            }
          }
          if (isK) dst = (u16*)(ws + OFF_K) + ((size_t)((b * 4 + hh) * 2 + mp) * LK + 256 + t) * 64;
          else dst = (u16*)(ws + OFF_Q) + ((size_t)((b * 4 + hh) * 2 + mp) * 8192 + t) * 64;
        } else {
          const int tc = tok - XTOK, b = tc >> 8, t = tc & 255;
          if (isK) dst = (u16*)(ws + OFF_K) + ((size_t)((b * 4 + hh) * 2 + mp) * LK + t) * 64;
          else dst = (u16*)(ws + OFF_QC) + ((size_t)((b * 4 + hh) * 2 + mp) * 256 + t) * 64;
        }
#pragma unroll
        for (int n = 0; n < 4; ++n) {
          uint2 o; o.x = pk2(v[n][0] * osc, v[n][1] * osc); o.y = pk2(v[n][2] * osc, v[n][3] * osc);
          *(uint2*)(dst + n * 16 + fq * 4) = o;
        }
      }
    } else if (nt < 12) {
      const int hh = nt - 8;
      u16* vt = (u16*)(ws + OFF_VT);
#pragma unroll
      for (int m = 0; m < 4; ++m) {
        const int tok = tok0 + m * 16;
        int b, key;
        if (!isctx) { b = tok >> 13; key = 256 + (tok & 8191); } else { const int tc = tok - XTOK; b = tc >> 8; key = tc & 255; }
        const size_t base = ((size_t)(b * 4 + hh) * NKT + (key >> 5)) * 128 * 32 + (key & 31);
#pragma unroll
        for (int n = 0; n < 4; ++n)
#pragma unroll
          for (int j = 0; j < 4; ++j) { const int dv = wc * 64 + n * 16 + fq * 4 + j; vt[base + (size_t)dv * 32] = bf1(acc[m][n][j]); }
      }
    } else {
      float* dstb = (float*)(ws + (nt < 14 ? OFF_U : OFF_F));
      const int c0 = (nt & 1) * 128 + wc * 64 + fq * 4;
#pragma unroll
      for (int m = 0; m < 4; ++m) {
        const int tok = tok0 + m * 16;
#pragma unroll
        for (int n = 0; n < 4; ++n) *(f32x4*)(dstb + (size_t)tok * 256 + c0 + n * 16) = acc[m][n];
      }
    }
  } else if (EPI == EPI_OUT || EPI == EPI_FF2) {
    const float* gate = modl + (EPI == EPI_OUT ? 2048 : 5120);
    const bool last = (EPI == EPI_FF2) && (layer == DEPTH - 1);
    const float* xin = (EPI == EPI_OUT) ? xa_rd_tile(p, layer, mt) : (const float*)xb_tile(p, mt);
    float* xout = (EPI == EPI_OUT || last) ? xb_tile(p, mt) : xa_tile(p, mt);
#pragma unroll
    for (int m = 0; m < 4; ++m) {
      const int lrow = wr * 64 + m * 16 + fr;
#pragma unroll
      for (int n = 0; n < 4; ++n) {
        const int f = f0 + n * 16;
        const f32x4 gv = *(const f32x4*)(gate + f);
        f32x4 xv = *(const f32x4*)(xin + (size_t)lrow * 1024 + f);
        xv = xv + gv * acc[m][n];
        *(f32x4*)(xout + (size_t)lrow * 1024 + f) = xv;
      }
    }
  } else if (EPI == EPI_FF1) {
    u16* hid = (u16*)(ws + OFF_HID);
#pragma unroll
    for (int m = 0; m < 4; ++m) {
      const int tok = tok0 + m * 16;
#pragma unroll
      for (int n = 0; n < 4; ++n) {
        f32x4 a = acc[m][n];
#pragma unroll
        for (int j = 0; j < 4; ++j) { const float r = fmaxf(a[j], 0.f); a[j] = r * r; }
        uint2 o; o.x = pk2(a[0], a[1]); o.y = pk2(a[2], a[3]);
        *(uint2*)(hid + (size_t)tok * DFF + f0 + n * 16) = o;
      }
    }
  } else if (EPI == EPI_GLU) {
    const u16* hg = (const u16*)(ws + OFF_HGLU);
    u16* mix = (u16*)(ws + OFF_MIX);
    const float* bg = p.b_glu + layer * 256;
#pragma unroll
    for (int m = 0; m < 4; ++m) {
      const int tok = tok0 + m * 16;
#pragma unroll
      for (int n = 0; n < 4; ++n) {
        const int f = f0 + n * 16;
        const uint2 hv = *(const uint2*)(hg + (size_t)tok * 256 + f);
        const f32x4 bv = *(const f32x4*)(bg + f);
        float h[4] = {bf2f((u16)(hv.x & 0xffff)), bf2f((u16)(hv.x >> 16)), bf2f((u16)(hv.y & 0xffff)), bf2f((u16)(hv.y >> 16))};
        float o[4];
#pragma unroll
        for (int j = 0; j < 4; ++j) { const float z = acc[m][n][j] + bv[j]; o[j] = h[j] / (1.f + __expf(-z)); }
        uint2 ov; ov.x = pk2(o[0], o[1]); ov.y = pk2(o[2], o[3]);
        *(uint2*)(mix + (size_t)tok * 1024 + 512 + f) = ov;
      }
    }
  }
}

DI void attn_unit(const P& p, int layer, int u, char* smem, char* smem_o) {
  const int tid = get_tid(), lane = tid & 63, w = tid >> 6, l32 = lane & 31, hf = lane >> 5;
  char* ws = p.ws;
  int b, hh, qb, nkt, lq; const u16* Qsrc; int tokbase;
  if (u < 512) { b = u >> 8; hh = (u >> 6) & 3; qb = u & 63; nkt = NKT; lq = 8192; Qsrc = (const u16*)(ws + OFF_Q); tokbase = b * 8192 + qb * 128; }
  else { const int uu = u - 512; b = uu >> 3; hh = (uu >> 1) & 3; qb = uu & 1; nkt = 8; lq = 256; Qsrc = (const u16*)(ws + OFF_QC); tokbase = XTOK + b * 256 + qb * 128; }
  const u16* Q0 = Qsrc + ((size_t)((b * 4 + hh) * 2) * lq + qb * 128) * 64;
  const u16* K0 = (const u16*)(ws + OFF_K) + (size_t)((b * 4 + hh) * 2) * LK * 64;
  const u16* V0 = (const u16*)(ws + OFF_VT) + (size_t)(b * 4 + hh) * NKT * 4096;
  u16* Qs = (u16*)smem;
  u16* KV = Qs + 2 * 128 * LDT;
  constexpr int KVSTRIDE = 32 * LDT + 64 * 40;
  const bool hi = smem_o < smem;
  const u16* KVo = (const u16*)smem_o + 2 * 128 * LDT;
  const u16* kbase0 = hi ? KVo : KV;
  const u16* kbase1 = hi ? KV : KVo;
  const float lam = ((const float*)(ws + OFF_SMALL))[layer];
  __syncthreads();
#pragma unroll
  for (int i = 0; i < 8; ++i) {
    const int pi = tid + 256 * i;
    const int mp = pi >> 10, row = (pi >> 3) & 127, seg = pi & 7;
    *(uint4*)(Qs + (mp * 128 + row) * LDT + seg * 8) = *(const uint4*)(Q0 + (size_t)mp * lq * 64 + row * 64 + seg * 8);
  }
  uint4 kr0, vr0;
#define AGLOAD(kt)                                                                         \
  do {                                                                                     \
    kr0 = *(const uint4*)(K0 + (hi ? (size_t)LK * 64 : (size_t)0) + (size_t)(kt) * 2048 + tid * 8); \
    vr0 = *(const uint4*)(V0 + (size_t)(kt) * 4096 + (hi ? 2048 : 0) + tid * 8);           \
  } while (0)
#define ALSTORE(buf)                                                                       \
  do {                                                                                     \
    u16* kb = KV + (buf) * KVSTRIDE;                                                       \
    *(uint4*)(kb + (tid >> 3) * LDT + (tid & 7) * 8) = kr0;                                \
    u16* vb = kb + 32 * LDT;                                                               \
    *(uint4*)(vb + (tid >> 2) * 40 + (tid & 3) * 8) = vr0;                                 \
  } while (0)
  AGLOAD(0);
  ALSTORE(0);
  __syncthreads();

  f32x16 o1[4], o2[4];
#pragma unroll
  for (int i = 0; i < 4; ++i)
#pragma unroll
    for (int j = 0; j < 16; ++j) { o1[i][j] = 0.f; o2[i][j] = 0.f; }
  float l1 = 0.f, l2 = 0.f;
  const u16* qrow = Qs + (w * 32 + l32) * LDT + hf * 8;

  const bf16x8 qa0 = *(const bf16x8*)(qrow), qa1 = *(const bf16x8*)(qrow + 16);
  for (int kt = 0; kt < nkt; ++kt) {
    const int buf = kt & 1;
    if (kt + 1 < nkt) AGLOAD(kt + 1);
    const u16* kb0 = kbase0 + buf * KVSTRIDE;
    const u16* kb1 = kbase1 + buf * KVSTRIDE;
    f32x16 s1, s2;
#pragma unroll
    for (int j = 0; j < 16; ++j) { s1[j] = 0.f; s2[j] = 0.f; }
#pragma unroll
    for (int kk = 0; kk < 4; ++kk) {
      const bf16x8 kf1 = *(const bf16x8*)(kb0 + l32 * LDT + kk * 16 + hf * 8);
      s1 = mfma32(kf1, kk == 0 ? qa0 : (kk == 1 ? qa1 : *(const bf16x8*)(qrow + kk * 16)), s1);
      const bf16x8 kf2 = *(const bf16x8*)(kb1 + l32 * LDT + kk * 16 + hf * 8);
      const bf16x8 qf2 = *(const bf16x8*)(qrow + 128 * LDT + kk * 16);
      s2 = mfma32(kf2, qf2, s2);
    }
    bf16x8 pf1[2], pf2[2];
    {
      unsigned pk[8], pq[8];
#pragma unroll
      for (int j = 0; j < 8; ++j) {
        const float a0 = __builtin_amdgcn_exp2f(s1[2 * j]), a1 = __builtin_amdgcn_exp2f(s1[2 * j + 1]);
        const float c0 = __builtin_amdgcn_exp2f(s2[2 * j]), c1 = __builtin_amdgcn_exp2f(s2[2 * j + 1]);
        l1 += a0 + a1; l2 += c0 + c1;
        pk[j] = pk2(a0, a1); pq[j] = pk2(c0, c1);
      }
      typedef unsigned u32x4 __attribute__((ext_vector_type(4)));
      pf1[0] = __builtin_bit_cast(bf16x8, (u32x4){pk[0], pk[1], pk[2], pk[3]});
      pf1[1] = __builtin_bit_cast(bf16x8, (u32x4){pk[4], pk[5], pk[6], pk[7]});
      pf2[0] = __builtin_bit_cast(bf16x8, (u32x4){pq[0], pq[1], pq[2], pq[3]});
      pf2[1] = __builtin_bit_cast(bf16x8, (u32x4){pq[4], pq[5], pq[6], pq[7]});
    }
#pragma unroll
    for (int blk = 0; blk < 4; ++blk) {
#pragma unroll
      for (int s = 0; s < 2; ++s) {
        const u16* vp = (blk < 2 ? kb0 : kb1) + 32 * LDT + ((blk & 1) * 32 + l32) * 40 + 16 * s + 4 * hf;
        const uint2 lo = *(const uint2*)vp, hi = *(const uint2*)(vp + 8);
        typedef unsigned u32x4 __attribute__((ext_vector_type(4)));
        const bf16x8 vf = __builtin_bit_cast(bf16x8, (u32x4){lo.x, lo.y, hi.x, hi.y});
        o1[blk] = mfma32(vf, pf1[s], o1[blk]);
        o2[blk] = mfma32(vf, pf2[s], o2[blk]);
      }
    }
    if (kt + 1 < nkt) ALSTORE(buf ^ 1);
    __syncthreads();
  }
#undef AGLOAD
#undef ALSTORE
  l1 += __shfl_xor(l1, 32); l2 += __shfl_xor(l2, 32);
  const float i1 = 1.f / l1, i2 = lam / l2;
  float ss = 0.f;
#pragma unroll
  for (int blk = 0; blk < 4; ++blk)
#pragma unroll
    for (int j = 0; j < 16; ++j) { const float v = o1[blk][j] * i1 - o2[blk][j] * i2; o1[blk][j] = v; ss += v * v; }
  ss += __shfl_xor(ss, 32);
  const float rstd = rsqrtf(ss * (1.f / 128.f) + EPS) * (1.f - lam_init_of(layer));
  const float* gs = p.g_subln + layer * 128;
  u16* mix = (u16*)(ws + OFF_MIX) + (size_t)(tokbase + w * 32 + l32) * 1024 + hh * 128;
#pragma unroll
  for (int blk = 0; blk < 4; ++blk)
#pragma unroll
    for (int g4 = 0; g4 < 4; ++g4) {
      const int dv = blk * 32 + 8 * g4 + 4 * hf;
      const float4 gv = *(const float4*)(gs + dv);
      uint2 o;
      o.x = pk2(o1[blk][4 * g4] * rstd * gv.x, o1[blk][4 * g4 + 1] * rstd * gv.y);
      o.y = pk2(o1[blk][4 * g4 + 2] * rstd * gv.z, o1[blk][4 * g4 + 3] * rstd * gv.w);
      *(uint2*)(mix + dv) = o;
    }
}

template <bool FINAL, bool HORNER>
DI void ssm_unit(const P& p, int layer, int b, int blk, char* smem) {
  const int tid = get_tid(), lane = tid & 63, w = tid >> 6, fr = lane & 15, fq = lane >> 4;
  char* ws = p.ws;
  int tok0, cf, cr;
  if (blk < 256) { tok0 = b * 8192 + blk * 32; cf = 8 + blk; cr = 8 + 255 - blk; }
  else { const int cb = blk - 256; tok0 = XTOK + b * 256 + cb * 32; cf = cb; cr = 7 - cb; }
  u16* ub = (u16*)smem;
  float* BUw = (float*)(smem + 16896) + w * 16 * 132;
  __syncthreads();
  {
    const float4* src = (const float4*)((const float*)(ws + OFF_U) + (size_t)tok0 * 256);
#pragma unroll
    for (int i = 0; i < 8; ++i) {
      const int e = tid + 256 * i, row = e >> 6, c4 = (e & 63) * 4;
      const float4 v = src[e];
      uint2 o; o.x = pk2(v.x, v.y); o.y = pk2(v.z, v.w);
      *(uint2*)(ub + row * 264 + c4) = o;
    }
  }
  __syncthreads();
  const float2* AB = (const float2*)(ws + OFF_AB);
  const u16* BBH = (const u16*)(ws + OFF_BBH);
  const u16* CM = (const u16*)(ws + OFF_CM);
  float2* LOC = (float2*)(ws + OFF_LOCAL);
  const float2* CAR = (const float2*)(ws + OFF_CARRY);
  const bf16x8 zero8 = {0, 0, 0, 0, 0, 0, 0, 0};
  for (int gi = 0; gi < 4; ++gi) {
    const int g = w * 4 + gi;
    f32x4 y0 = (f32x4){0.f, 0.f, 0.f, 0.f}, y1 = (f32x4){0.f, 0.f, 0.f, 0.f};
#pragma unroll
    for (int dir = 0; dir < 2; ++dir) {
      const int sidx = ((layer * 2 + dir) * 16 + g) * 64 + lane;
      const float2 a = AB[sidx];
      const int chunk = dir ? cr : cf;
      const size_t cidx = ((size_t)((b * 2 + dir) * NCH + chunk) * 16 + g) * 64 + lane;
      float sr, si;
      if (FINAL && !HORNER) { const float2 c0 = CAR[cidx]; sr = c0.x; si = c0.y; }
      else { opaque_zero2(sr, si); }
      if (FINAL && HORNER) {
        const float2 aT = ((const float2*)(ws + OFF_AT))[sidx];
        const float2* lp = LOC + ((size_t)((b * 2 + dir) * NCH) * 16 + g) * 64 + lane;
        for (int c = 0; c < chunk; ++c) {
          const float2 lo = lp[(size_t)c * 1024];
          const float nr = aT.x * sr - aT.y * si + lo.x, ni = aT.x * si + aT.y * sr + lo.y;
          sr = nr; si = ni;
        }
      }
      const u16* bbp = BBH + ((size_t)((layer * 2 + dir) * 16 + g) * 128 + fr) * 16 + (fq & 1) * 8;
      const u16* cmp = CM + ((size_t)((layer * 2 + dir) * 16 + g) * 16 + fr) * 128 + fq * 8;
      bf16x8 bfr0 = *(const bf16x8*)(bbp), bfr1 = *(const bf16x8*)(bbp + 256), bfr2 = *(const bf16x8*)(bbp + 512), bfr3 = *(const bf16x8*)(bbp + 768);
      bf16x8 bfr4 = *(const bf16x8*)(bbp + 1024), bfr5 = *(const bf16x8*)(bbp + 1280), bfr6 = *(const bf16x8*)(bbp + 1536), bfr7 = *(const bf16x8*)(bbp + 1792);
      if (fq >= 2) { bfr0 = zero8; bfr1 = zero8; bfr2 = zero8; bfr3 = zero8; bfr4 = zero8; bfr5 = zero8; bfr6 = zero8; bfr7 = zero8; }
      bf16x8 cf0 = zero8, cf1 = zero8, cf2 = zero8, cf3 = zero8;
      if (FINAL) { cf0 = *(const bf16x8*)(cmp); cf1 = *(const bf16x8*)(cmp + 32); cf2 = *(const bf16x8*)(cmp + 64); cf3 = *(const bf16x8*)(cmp + 96); }
#pragma unroll
      for (int hh = 0; hh < 2; ++hh) {
        const int tb = dir ? 1 - hh : hh;
        {
          const bf16x8 ufl = *(const bf16x8*)(ub + (tb * 16 + fr) * 264 + g * 16 + (fq & 1) * 8);
          const bf16x8 uf = fq < 2 ? ufl : zero8;
#define BU_(CBI, BF) do { const f32x4 d = mfma16(BF, uf, (f32x4){0.f, 0.f, 0.f, 0.f}); *(f32x4*)(BUw + fr * 132 + (CBI) * 16 + fq * 4) = d; } while (0)
          BU_(0, bfr0); BU_(1, bfr1); BU_(2, bfr2); BU_(3, bfr3); BU_(4, bfr4); BU_(5, bfr5); BU_(6, bfr6); BU_(7, bfr7);
#undef BU_
        }
        __syncthreads();
#pragma unroll 4
        for (int tt = 0; tt < 16; ++tt) {
          const int tl = dir ? 15 - tt : tt;
          const float2 bu = *(const float2*)(BUw + tl * 132 + 2 * lane);
          const float nr = a.x * sr - a.y * si + bu.x, ni = a.x * si + a.y * sr + bu.y;
          sr = nr; si = ni;
          if (FINAL) { u16* srow = (u16*)(BUw + tl * 132); srow[lane] = bf1(sr); srow[64 + lane] = bf1(si); }
        }
        __syncthreads();
        if (FINAL) {
          f32x4 yy = tb == 0 ? y0 : y1;
          const u16* sp = (const u16*)(BUw + fr * 132) + fq * 8;
          yy = mfma16(cf0, *(const bf16x8*)(sp), yy);
          yy = mfma16(cf1, *(const bf16x8*)(sp + 32), yy);
          yy = mfma16(cf2, *(const bf16x8*)(sp + 64), yy);
          yy = mfma16(cf3, *(const bf16x8*)(sp + 96), yy);
          if (tb == 0) y0 = yy; else y1 = yy;
          __syncthreads();
        }
      }
      if (!FINAL) LOC[cidx] = make_float2(sr, si);
    }
    if (FINAL) {
      const int ch = g * 16 + fq * 4;
      const float4 dsk = *(const float4*)(p.ssm_d + layer * 256 + ch);
      u16* hg = (u16*)(ws + OFF_HGLU);
#pragma unroll
      for (int tb = 0; tb < 2; ++tb) {
        const int t = tb * 16 + fr;
        const f32x4 yv = tb == 0 ? y0 : y1;
        const uint2 uraw = *(const uint2*)(ub + t * 264 + ch);
        const float u0 = bf2f((u16)(uraw.x & 0xffff)), u1 = bf2f((u16)(uraw.x >> 16)), u2 = bf2f((u16)(uraw.y & 0xffff)), u3 = bf2f((u16)(uraw.y >> 16));
        const float r0 = gelu_tanh(yv[0] + dsk.x * u0), r1 = gelu_tanh(yv[1] + dsk.y * u1);
        const float r2 = gelu_tanh(yv[2] + dsk.z * u2), r3 = gelu_tanh(yv[3] + dsk.w * u3);
        uint2 o; o.x = pk2(r0, r1); o.y = pk2(r2, r3);
        *(uint2*)(hg + (size_t)(tok0 + t) * 256 + ch) = o;
      }
    }
  }
}

DI void ssm_carry_unit(const P& p, int layer, int u, char* smem) {
  const int tid = get_tid(), seg = tid >> 5, sl = tid & 31;
  const int st = u * 32 + sl;
  const int gn = st & 1023, bd = st >> 10, dir = bd & 1;
  float2* tot = (float2*)smem;
  const float2 aT = ((const float2*)(p.ws + OFF_AT))[((layer * 2 + dir) * 1024) + gn];
  const float2* LOC = (const float2*)(p.ws + OFF_LOCAL) + (size_t)bd * NCH * 1024 + gn + (size_t)seg * 33 * 1024;
  float2* CAR = (float2*)(p.ws + OFF_CARRY) + (size_t)bd * NCH * 1024 + gn + (size_t)seg * 33 * 1024;
  __syncthreads();
  float sr, si;
  opaque_zero2(sr, si);
  float pr = 1.f, pi = 0.f;
#pragma unroll 11
  for (int j = 0; j < 33; ++j) {
    const float2 lo = LOC[(size_t)j * 1024];
    const float nr = aT.x * sr - aT.y * si + lo.x, ni = aT.x * si + aT.y * sr + lo.y;
    sr = nr; si = ni;
    const float qr = pr * aT.x - pi * aT.y, qi = pr * aT.y + pi * aT.x;
    pr = qr; pi = qi;
  }
  tot[seg * 32 + sl] = make_float2(sr, si);
  __syncthreads();
  opaque_zero2(sr, si);
  for (int k = 0; k < seg; ++k) {
    const float2 t = tot[k * 32 + sl];
    const float nr = pr * sr - pi * si + t.x, ni = pr * si + pi * sr + t.y;
    sr = nr; si = ni;
  }
#pragma unroll 11
  for (int j = 0; j < 33; ++j) {
    CAR[(size_t)j * 1024] = make_float2(sr, si);
    const float2 lo = LOC[(size_t)j * 1024];
    const float nr = aT.x * sr - aT.y * si + lo.x, ni = aT.x * si + aT.y * sr + lo.y;
    sr = nr; si = ni;
  }
}

DI void fft1_unit(const P& p, int u, char* smem) {
  const int tid = get_tid(), lane = tid & 63, w = tid >> 6, fr = lane & 15, fq = lane >> 4;
  const int b = u >> 8, col = (u >> 2) & 63, g = u & 3;
  u16* Ht = (u16*)smem;
  __syncthreads();
  const float* F = (const float*)(p.ws + OFF_F);
#pragma unroll
  for (int i = 0; i < 8; ++i) {
    const int r = (tid >> 4) + 16 * i, c4 = (tid & 15) * 4;
    const float4 v = *(const float4*)(F + (size_t)(b * 8192 + 64 * r + col) * 256 + g * 64 + c4);
    Ht[(c4 + 0) * 136 + r] = bf1(v.x); Ht[(c4 + 1) * 136 + r] = bf1(v.y); Ht[(c4 + 2) * 136 + r] = bf1(v.z); Ht[(c4 + 3) * 136 + r] = bf1(v.w);
  }
  __syncthreads();
  f32x4 acc[4][4];
#pragma unroll
  for (int n = 0; n < 4; ++n)
#pragma unroll
    for (int m = 0; m < 4; ++m) acc[n][m] = (f32x4){0.f, 0.f, 0.f, 0.f};
  const u16* D = (const u16*)(p.ws + OFF_D128);
#pragma unroll
  for (int kk = 0; kk < 4; ++kk) {
    bf16x8 hfv[4], df[4];
#pragma unroll
    for (int n = 0; n < 4; ++n) hfv[n] = *(const bf16x8*)(Ht + (n * 16 + fr) * 136 + kk * 32 + fq * 8);
#pragma unroll
    for (int m = 0; m < 4; ++m) df[m] = *(const bf16x8*)(D + (size_t)(64 * w + 16 * m + fr) * 128 + kk * 32 + fq * 8);
#pragma unroll
    for (int n = 0; n < 4; ++n)
#pragma unroll
      for (int m = 0; m < 4; ++m) acc[n][m] = mfma16(hfv[n], df[m], acc[n][m]);
  }
  float* T = (float*)(p.ws + OFF_T);
#pragma unroll
  for (int m = 0; m < 4; ++m) {
    const int dr = 64 * w + 16 * m + fr, ri = dr >> 7, k1 = dr & 127;
    float* dst = T + ((size_t)(((b * 4 + g) * 128 + k1) * 2 + ri) * 64 + col) * 64;
#pragma unroll
    for (int n = 0; n < 4; ++n) *(f32x4*)(dst + n * 16 + fq * 4) = acc[n][m];
  }
}

DI void fft2_unit(const P& p, int layer, int u, char* smem) {
  const int tid = get_tid(), lane = tid & 63, w = tid >> 6, fr = lane & 15, fq = lane >> 4;
  const int b = u >> 9, k1 = (u >> 2) & 127, g = u & 3;
  u16* Xt = (u16*)smem;
  u16* Gt = Xt + 64 * 136;
  __syncthreads();
  const float* T = (const float*)(p.ws + OFF_T) + (size_t)(((b * 4 + g) * 128 + k1) * 2) * 4096;
  const float2* TW = (const float2*)(p.ws + OFF_TW) + k1 * 64;
#pragma unroll
  for (int i = 0; i < 4; ++i) {
    const int col = (tid >> 4) + 16 * i, c4 = (tid & 15) * 4;
    const float4 re = *(const float4*)(T + col * 64 + c4), im = *(const float4*)(T + 4096 + col * 64 + c4);
    const float2 tw = TW[col];
    const float rr[4] = {re.x, re.y, re.z, re.w}, ii[4] = {im.x, im.y, im.z, im.w};
#pragma unroll
    for (int e = 0; e < 4; ++e) {
      Xt[(c4 + e) * 136 + col] = bf1(rr[e] * tw.x - ii[e] * tw.y);
      Xt[(c4 + e) * 136 + 64 + col] = bf1(rr[e] * tw.y + ii[e] * tw.x);
    }
  }
  __syncthreads();
  {
    f32x4 acc[4][2];
#pragma unroll
    for (int n = 0; n < 4; ++n) { acc[n][0] = (f32x4){0.f, 0.f, 0.f, 0.f}; acc[n][1] = (f32x4){0.f, 0.f, 0.f, 0.f}; }
    const u16* D = (const u16*)(p.ws + OFF_D64);
#pragma unroll
    for (int kk = 0; kk < 4; ++kk) {
      bf16x8 xf[4], df[2];
#pragma unroll
      for (int n = 0; n < 4; ++n) xf[n] = *(const bf16x8*)(Xt + (n * 16 + fr) * 136 + kk * 32 + fq * 8);
#pragma unroll
      for (int m = 0; m < 2; ++m) df[m] = *(const bf16x8*)(D + (size_t)(32 * w + 16 * m + fr) * 128 + kk * 32 + fq * 8);
#pragma unroll
      for (int n = 0; n < 4; ++n)
#pragma unroll
        for (int m = 0; m < 2; ++m) acc[n][m] = mfma16(xf[n], df[m], acc[n][m]);
    }
#pragma unroll
    for (int m = 0; m < 2; ++m) {
      const int row2 = 32 * w + 16 * m + fr, ri = row2 >> 6, k2 = row2 & 63;
#pragma unroll
      for (int n = 0; n < 4; ++n) {
        uint2 o; o.x = pk2(acc[n][m][0], acc[n][m][1]); o.y = pk2(acc[n][m][2], acc[n][m][3]);
        *(uint2*)(Gt + k2 * 136 + ri * 64 + n * 16 + fq * 4) = o;
      }
    }
  }
  __syncthreads();
  {
    f32x4 acc[4];
#pragma unroll
    for (int n = 0; n < 4; ++n) acc[n] = (f32x4){0.f, 0.f, 0.f, 0.f};
    const u16* W = (const u16*)(p.ws + OFF_WCS) + (size_t)(layer * 4 + g) * 64 * 128;
#pragma unroll
    for (int kk = 0; kk < 4; ++kk) {
      const bf16x8 gf = *(const bf16x8*)(Gt + (16 * w + fr) * 136 + kk * 32 + fq * 8);
#pragma unroll
      for (int n = 0; n < 4; ++n) {
        const bf16x8 wf = *(const bf16x8*)(W + (size_t)(n * 16 + fr) * 128 + kk * 32 + fq * 8);
        acc[n] = mfma16(wf, gf, acc[n]);
      }
    }
    const int k2 = 16 * w + fr;
    u16* mix = (u16*)(p.ws + OFF_MIX) + (size_t)(b * 8192 + k1 + 128 * k2) * 1024 + 768 + g * 64;
#pragma unroll
    for (int n = 0; n < 4; ++n) {
      uint2 o; o.x = pk2(acc[n][0], acc[n][1]); o.y = pk2(acc[n][2], acc[n][3]);
      *(uint2*)(mix + n * 16 + fq * 4) = o;
    }
  }
}

DI void ctxfft_unit(const P& p, int layer, int u, char* smem) {
  const int tid = get_tid();
  const int b = u >> 6, g = (u >> 4) & 3, kb = u & 15;
  float2* tab = (float2*)smem;
  float* Gs = (float*)(smem + 2048);
  float* zs = Gs + 16 * 128;
  __syncthreads();
  { const float ang = 6.283185307179586f * (float)tid / 256.f; tab[tid] = make_float2(cosf(ang), sinf(ang)); }
  __syncthreads();
  const int kl = tid >> 4, c4 = (tid & 15) * 4, k = kb * 16 + kl;
  const float* F = (const float*)(p.ws + OFF_F) + (size_t)(XTOK + b * 256) * 256 + g * 64 + c4;
  float gr[4] = {0.f, 0.f, 0.f, 0.f}, gim[4] = {0.f, 0.f, 0.f, 0.f};
#pragma unroll 16
  for (int l = 0; l < 256; ++l) {
    const float4 hv = *(const float4*)(F + (size_t)l * 256);
    const float2 cs = tab[(k * l) & 255];
    gr[0] += cs.x * hv.x; gr[1] += cs.x * hv.y; gr[2] += cs.x * hv.z; gr[3] += cs.x * hv.w;
    gim[0] -= cs.y * hv.x; gim[1] -= cs.y * hv.y; gim[2] -= cs.y * hv.z; gim[3] -= cs.y * hv.w;
  }
#pragma unroll
  for (int e = 0; e < 4; ++e) { Gs[kl * 128 + c4 + e] = gr[e]; Gs[kl * 128 + 64 + c4 + e] = gim[e]; }
  __syncthreads();
  float z[4] = {0.f, 0.f, 0.f, 0.f};
  for (int c = 0; c < 64; ++c) {
    const float a = Gs[kl * 128 + c], bi = Gs[kl * 128 + 64 + c];
#pragma unroll
    for (int e = 0; e < 4; ++e) { const float2 cs = tab[((c * (c4 + e)) & 63) * 4]; z[e] += a * cs.x + bi * cs.y; }
  }
#pragma unroll
  for (int e = 0; e < 4; ++e) zs[kl * 64 + c4 + e] = z[e] * (1.f / 128.f);
  __syncthreads();
  const float* wf = p.w_fnet + (size_t)(layer * 4 + g) * 4096;
  float o[4] = {0.f, 0.f, 0.f, 0.f};
  for (int cp = 0; cp < 64; ++cp) {
    const float zv = zs[kl * 64 + cp];
    const float4 wv = *(const float4*)(wf + cp * 64 + c4);
    o[0] += zv * wv.x; o[1] += zv * wv.y; o[2] += zv * wv.z; o[3] += zv * wv.w;
  }
  u16* mix = (u16*)(p.ws + OFF_MIX) + (size_t)(XTOK + b * 256 + k) * 1024 + 768 + g * 64 + c4;
  uint2 ov; ov.x = pk2(o[0], o[1]); ov.y = pk2(o[2], o[3]);
  *(uint2*)mix = ov;
}


#define XB_TMO      128
#define XB_XCNT(j)  (256  + 64 * (j))
#define XB_XSUB(j)  (1280 + 64 * (j))
#define XB_XGEN(j)  (2304 + 64 * (j))
#define XB_TOP      3328
#define XB_TOPGEN   3392
#define XB_SPIN_CAP (1u << 18)
#define LAS __attribute__((address_space(3)))
DI unsigned xb_ld(unsigned* q) { return __hip_atomic_load(q, __ATOMIC_RELAXED, __HIP_MEMORY_SCOPE_AGENT); }
DI unsigned xb_add(unsigned* q, unsigned v) { return __hip_atomic_fetch_add(q, v, __ATOMIC_RELAXED, __HIP_MEMORY_SCOPE_AGENT); }
DI unsigned xb_xcc_id() { return (unsigned)__builtin_amdgcn_s_getreg((3 << 11) | 20) & 0xFu; }
#define XB_SPIN(cond, bar) do { unsigned _sp = 0; while (cond) { __builtin_amdgcn_s_sleep(1); \
    if ((++_sp & 255u) == 0u) { if (xb_ld(&(bar)[XB_TMO])) break; if (_sp > XB_SPIN_CAP) { atomicAdd(&(bar)[XB_TMO], 1u); break; } } } } while (0)
struct XcdBarrier { unsigned* bar; unsigned x; volatile LAS unsigned* st; };
DI XcdBarrier xcd_barrier_post(unsigned* bar, volatile LAS unsigned* st) {
  XcdBarrier b; b.bar = bar; b.x = xb_xcc_id(); b.st = st;
  if (threadIdx.x == 0) (void)xb_add(&bar[XB_XCNT(b.x)], 1u);
  return b;
}
DI void xcd_barrier_complete(unsigned* bar, unsigned x, unsigned& nloc, unsigned& nx) {
  const unsigned G = gridDim.x * gridDim.y * gridDim.z;
  unsigned sum, cnt, mine, sp = 0u;
  for (;;) {
    sum = 0u; cnt = 0u; mine = 0u;
#pragma unroll
    for (unsigned j = 0; j < 16; ++j) { const unsigned c = xb_ld(&bar[XB_XCNT(j)]); sum += c; cnt += (c > 0u) ? 1u : 0u; mine = (j == x) ? c : mine; }
    if (sum == G) break;
    __builtin_amdgcn_s_sleep(1);
    if ((++sp & 255u) == 0u) { if (xb_ld(&bar[XB_TMO])) break; if (sp > XB_SPIN_CAP) { atomicAdd(&bar[XB_TMO], 1u); break; } }
  }
  nloc = mine > 0u ? mine : 1u; nx = cnt > 0u ? cnt : 1u;
}
DI void xcd_barrier(const XcdBarrier& b) {
  asm volatile("s_waitcnt vmcnt(0)" ::: "memory");
  __syncthreads();
  if (threadIdx.x == 0) {
    unsigned* bar = b.bar;
    __builtin_amdgcn_s_waitcnt(0);
    unsigned nloc = b.st[0], nx = b.st[1];
    if (nloc == 0u) { xcd_barrier_complete(bar, b.x, nloc, nx); b.st[0] = nloc; b.st[1] = nx; }
    const unsigned old = xb_add(&bar[XB_XSUB(b.x)], 1u);
    const unsigned gen = old / nloc;
    if (old + 1u == (gen + 1u) * nloc) {
      __builtin_amdgcn_fence(__ATOMIC_RELEASE, "agent");
      asm volatile("s_waitcnt vmcnt(0)" ::: "memory");
      const unsigned og = xb_add(&bar[XB_TOP], 1u);
      const unsigned tg = og / nx;
      if (og + 1u == (tg + 1u) * nx) xb_add(&bar[XB_TOPGEN], 1u);
      else XB_SPIN(xb_ld(&bar[XB_TOPGEN]) == tg, bar);
      __builtin_amdgcn_fence(__ATOMIC_ACQUIRE, "agent");
      xb_add(&bar[XB_XGEN(b.x)], 1u);
      asm volatile("s_waitcnt vmcnt(0)" ::: "memory");
    } else {
      XB_SPIN(xb_ld(&bar[XB_XGEN(b.x)]) == gen, bar);
      __builtin_amdgcn_fence(__ATOMIC_ACQUIRE, "agent");
      asm volatile("s_waitcnt vmcnt(0)" ::: "memory");
    }
  }
  __syncthreads();
}

constexpr int NSUB = 10;
constexpr int NPHASE = 1 + DEPTH * NSUB;
DI int sub_of(int i) { return (int)((0x76d54983ba210cULL >> (4 * i)) & 15ULL); }

#define LOOPB(N, ROT, ...) do { const int n_ = (N); int br_ = B - (ROT); if (br_ < 0) br_ += G; \
    for (int u0_ = br_ & ~1; u0_ < n_; u0_ += G) { int u = u0_ + (br_ & 1); const bool dup = u >= n_; if (dup) u = n_ - 1; __VA_ARGS__; } } while (0)
#define LOOPG(N, CALL) do { const int n_ = (N); const int full_ = (n_ / G) * G; const int rem_ = n_ - full_; \
    for (int u = B; u < full_; u += G) { CALL(u, false, 0); } \
    if (rem_ > 0) { \
      if (rem_ * 2 <= G) { const int wg_ = B >> 1; if (wg_ < rem_) { CALL(full_ + wg_, false, (B & 1) + 1); } } \
      else { const int u0_ = full_ + (B & ~1); if (u0_ < n_) { int u = u0_ + (B & 1); const bool dup = u >= n_; if (dup) u = n_ - 1; CALL(u, dup, -1); } } \
    } } while (0)
#define LOOPN(N, ROT, ...) do { const int n_ = (N); int br_ = B - (ROT); if (br_ < 0) br_ += G; \
    for (int u = br_; u < n_; u += G) { __VA_ARGS__; } } while (0)

DI void run_phase(const P& p, int ph, char* smem) {
  const int G = gridDim.x * 2, B = blockIdx.x * 2 + __builtin_amdgcn_readfirstlane(threadIdx.x >> 8);
  char* ws = p.ws;
  char* smem_o = (B & 1) ? smem - LDS_BYTES : smem + LDS_BYTES;
  if (ph == 0) {
    LOOPB(11328, 0, prep_transposes(p, u, smem));
    LOOPB(384, 0, prep_mod(p, u, smem));
    LOOPN(32, 384, prep_disc(p, u));
    LOOPN(N_TABLE_UNITS, 0, prep_tables(p, u));
    LOOPN(512, 0, prep_wcs(p, u));
    LOOPN(1024, 0, prep_cm(p, u));
    return;
  }
  const int layer = (ph - 1) / NSUB, sub = (ph - 1) % NSUB;
  const bool lastl = layer == DEPTH - 1;
  const int nmt = lastl ? 128 : 132;
  switch (sub) {
    case 0: LOOPN(2112, 0, norm_unit(p, layer, 0, u)); break;
    case 1: {
      const u16* Wt = (const u16*)(ws + OFF_WIN) + (size_t)layer * 2048 * 1024;
#define CALL_(u, dup, role) gemm_unit<1, EPI_PROJ>(p, layer, (u) >> 4, (u) & 15, 1024, Wt, ws + OFF_HN, 1024, nullptr, nullptr, nullptr, smem, dup, role, smem_o)
      LOOPG(132 * 16, CALL_);
#undef CALL_
    } break;
    case 2: {
      LOOPB(512, 0, (ssm_unit<false, false>(p, layer, u >> 8, u & 255, smem)));
      LOOPB(16, 0, (ssm_unit<false, false>(p, layer, u >> 3, 256 + (u & 7), smem)));
      LOOPB(512, 0, fft1_unit(p, u, smem));
      if (!lastl) LOOPB(128, 16, ctxfft_unit(p, layer, u, smem));
    } break;
    case 3: {
      LOOPB(128, 0, ssm_carry_unit(p, layer, u, smem));
      if (!lastl) LOOPB(16, 128, (ssm_unit<true, true>(p, layer, u >> 3, 256 + (u & 7), smem)));
      if (!lastl) LOOPB(16, 144, attn_unit(p, layer, 512 + u, smem, smem_o));
      LOOPB(1024, 0, fft2_unit(p, layer, u, smem));
    } break;
    case 4: {
      LOOPB(512, 0, attn_unit(p, layer, u, smem, smem_o));
      LOOPB(512, 0, (ssm_unit<true, false>(p, layer, u >> 8, u & 255, smem)));
    } break;
    case 5: {
      const u16* Wt = (const u16*)(ws + OFF_WGLU) + (size_t)layer * 256 * 256;
      LOOPB(nmt * 2, 0, (gemm_unit<1, EPI_GLU>(p, layer, u >> 1, u & 1, 256, Wt, ws + OFF_HGLU, 256, nullptr, nullptr, nullptr, smem, dup)));
    } break;
    case 6: {
      const u16* Wt = (const u16*)(ws + OFF_WOUT) + (size_t)layer * 1024 * 1024;
#define CALL_(u, dup, role) gemm_unit<1, EPI_OUT>(p, layer, (u) >> 3, (u) & 7, 1024, Wt, ws + OFF_MIX, 1024, nullptr, nullptr, nullptr, smem, dup, role, smem_o)
      LOOPG(nmt * 8, CALL_);
#undef CALL_
    } break;
    case 7: LOOPN(nmt * 16, 0, norm_unit(p, layer, 1, u)); break;
    case 8: {
      const u16* Wt = (const u16*)(ws + OFF_WFF1) + (size_t)layer * 4096 * 1024;
#define CALL_(u, dup, role) gemm_unit<1, EPI_FF1>(p, layer, (u) >> 5, (u) & 31, 1024, Wt, ws + OFF_HN, 1024, nullptr, nullptr, nullptr, smem, dup, role, smem_o)
      LOOPG(nmt * 32, CALL_);
#undef CALL_
    } break;
    case 9: {
      const u16* Wt = (const u16*)(ws + OFF_WFF2) + (size_t)layer * 1024 * 4096;
#define CALL_(u, dup, role) gemm_unit<1, EPI_FF2>(p, layer, (u) >> 3, (u) & 7, 4096, Wt, ws + OFF_HID, 4096, nullptr, nullptr, nullptr, smem, dup, role, smem_o)
      LOOPG(nmt * 8, CALL_);
#undef CALL_
    } break;
  }
}

__global__ void __launch_bounds__(512) mega(P p, int ph_lo, int ph_hi, int coop) {
  __shared__ __attribute__((aligned(16))) char smem_all[2 * LDS_BYTES];
  __shared__ uint4 xb_words;
  char* smem = smem_all + __builtin_amdgcn_readfirstlane(threadIdx.x >> 8) * LDS_BYTES;
  if (threadIdx.x == 0) xb_words = make_uint4(0u, 0u, 0u, 0u);
  __syncthreads();
  XcdBarrier xb = xcd_barrier_post((unsigned*)(p.ws + OFF_BAR), (volatile LAS unsigned*)&xb_words);
  for (int ph = ph_lo; ph < ph_hi; ++ph) {
    P q = p;
    asm volatile("" : "+s"(q.ws));
    run_phase(q, ph, smem);
    if (coop && ph + 1 < ph_hi) {
      if (ph == ph_lo) {
        asm volatile("s_waitcnt vmcnt(0)" ::: "memory");
        cg::this_grid().sync();
        if (threadIdx.x < 64) {
          __builtin_amdgcn_fence(__ATOMIC_ACQUIRE, "agent");
          asm volatile("s_waitcnt vmcnt(0)" ::: "memory");
        }
        __syncthreads();
      } else {
        xcd_barrier(xb);
      }
    }
  }
}

#ifdef DBG_DUMP
__global__ void __launch_bounds__(256) dumpk(P p) {
  const size_t n = (size_t)XTOK * 1024;
  for (size_t i = (size_t)blockIdx.x * 256 + threadIdx.x; i < n; i += (size_t)gridDim.x * 256) {
#if DBG_DUMP == 0
    { const int cc = (int)(i & 1023); p.out[i] = (cc >= DBG_CLO && cc < DBG_CHI) ? bf2f(((const u16*)(p.ws + OFF_MIX))[i]) : 0.f; }
#elif DBG_DUMP == 8
    p.out[i] = i < (size_t)512 * 1024 ? bf2f(((const u16*)(p.ws + OFF_MIX))[(size_t)XTOK * 1024 + i]) : 0.f;
#elif DBG_DUMP == 9
    p.out[i] = i < (size_t)512 * 1024 ? ((const float*)(p.ws + OFF_XBUF))[(size_t)XTOK * 1024 + i] : 0.f;
#elif DBG_DUMP == 10
    p.out[i] = ((const float*)(p.ws + OFF_T))[i % ((size_t)8388608)];
#elif DBG_DUMP == 11
    p.out[i] = bf2f(((const u16*)(p.ws + OFF_WIN))[(size_t)3 * 2048 * 1024 + (i % ((size_t)2048 * 1024))]);
#elif DBG_DUMP == 13
    p.out[i] = bf2f(((const u16*)(p.ws + OFF_WIN))[(size_t)3 * 2048 * 1024 + (i % ((size_t)2048 * 1024))]) + ((const float*)(p.ws + OFF_MOD))[i % ((size_t)4 * 3 * 6144)];
#elif DBG_DUMP == 12
    p.out[i] = ((const float*)(p.ws + OFF_MOD))[i % ((size_t)4 * 3 * 6144)];
#elif DBG_DUMP == 1
    p.out[i] = ((const float*)(p.ws + OFF_XBUF))[i];
#elif DBG_DUMP == 2
    p.out[i] = bf2f(((const u16*)(p.ws + OFF_Q))[i % ((size_t)2*4*2*8192*64)]) + bf2f(((const u16*)(p.ws + OFF_K))[i % ((size_t)2*4*2*8448*64)]) + bf2f(((const u16*)(p.ws + OFF_VT))[i % ((size_t)2*4*8448*128)]);
#elif DBG_DUMP == 3
    p.out[i] = ((const float*)(p.ws + OFF_U))[i % ((size_t)NTOK*256)] + ((const float*)(p.ws + OFF_F))[i % ((size_t)NTOK*256)];
#elif DBG_DUMP == 4
    p.out[i] = bf2f(((const u16*)(p.ws + OFF_HGLU))[i % ((size_t)NTOK*256)]);
#endif
  }
}
#endif

extern "C" void kernel_launch(void* const* d_in, const int* in_sizes, int n_in, void* d_out, int out_size, void* d_ws, size_t ws_size,
                              hipStream_t stream) {
  static int grid_blocks = 0;
  if (!grid_blocks) {
    int dev = 0, cus = 0, per_cu = 0;
    hipGetDevice(&dev);
    hipDeviceGetAttribute(&cus, hipDeviceAttributeMultiprocessorCount, dev);
    hipOccupancyMaxActiveBlocksPerMultiprocessor(&per_cu, mega, 512, 0);
    if (per_cu < 1) per_cu = 1;
    if (per_cu > 1) per_cu = 1;
    grid_blocks = cus * per_cu;
  }
  if (ws_size < WS_NEED) { fprintf(stderr, "workspace too small: %zu < %zu\n", ws_size, (size_t)WS_NEED); return; }
  P p{};
  const float** pp = (const float**)&p;
  for (int i = 0; i < 30; ++i) pp[i] = (const float*)d_in[i];
  p.out = (float*)d_out;
  p.ws = (char*)d_ws;
#ifdef DBG_MEMSET
  hipMemsetAsync(d_ws, 0, WS_NEED, stream);
#endif
  hipMemsetAsync((char*)d_ws + OFF_BAR, 0, BAR_BYTES, stream);
#if COOP
#ifdef DBG_STOP
  int lo = 0, hi = DBG_STOP, coop = 1;
#else
  int lo = 0, hi = NPHASE, coop = 1;
#endif
  void* args[] = {&p, &lo, &hi, &coop};
  hipError_t e = hipLaunchCooperativeKernel((void*)mega, dim3(grid_blocks), dim3(512), args, 0, stream);
  if (e != hipSuccess) fprintf(stderr, "cooperative launch failed: %s (grid %d)\n", hipGetErrorString(e), grid_blocks);
#ifdef DBG_DUMP
  dumpk<<<dim3(1024), dim3(256), 0, stream>>>(p);
#endif
#else
#ifdef DBG_STOP
  for (int ph = 0; ph < DBG_STOP; ++ph) mega<<<dim3(grid_blocks), dim3(512), 0, stream>>>(p, ph, ph + 1, 0);
#else
  for (int ph = 0; ph < NPHASE; ++ph) mega<<<dim3(grid_blocks), dim3(512), 0, stream>>>(p, ph, ph + 1, 0);
#endif
#ifdef DBG_DUMP
  dumpk<<<dim3(1024), dim3(256), 0, stream>>>(p);
#endif
#endif
}
```

```cpp
#include <hip/hip_runtime.h>
#include <hip/hip_cooperative_groups.h>
#include <cstdio>
#include <cstdint>
namespace cg = cooperative_groups;

#ifndef COOP
#define COOP 1
#endif

#define DI __device__ __forceinline__
typedef unsigned short u16;
typedef short bf16x8 __attribute__((ext_vector_type(8)));
typedef float f32x4 __attribute__((ext_vector_type(4)));
typedef float f32x16 __attribute__((ext_vector_type(16)));
typedef __bf16 bf16v2 __attribute__((ext_vector_type(2)));
typedef float f32v2 __attribute__((ext_vector_type(2)));

constexpr int DM = 1024, NBATCH = 2, SEQ = 8192, DEPTH = 4, CTX = 256;
constexpr int XTOK = NBATCH * SEQ;
constexpr int NTOK = XTOK + NBATCH * CTX;
constexpr int LK = CTX + SEQ;
constexpr int NKT = LK / 32;
constexpr int NCH = LK / 32;
constexpr int DFF = 4096;
constexpr int LDS_BYTES = 77824;
constexpr float EPS = 1e-6f;
constexpr float LOG2E = 1.4426950408889634f;

constexpr size_t AL(size_t x) { return (x + 255) & ~(size_t)255; }
constexpr size_t OFF_WIN = 0;
constexpr size_t OFF_WOUT = OFF_WIN + AL((size_t)DEPTH * 2048 * 1024 * 2);
constexpr size_t OFF_WFF1 = OFF_WOUT + AL((size_t)DEPTH * 1024 * 1024 * 2);
constexpr size_t OFF_WFF2 = OFF_WFF1 + AL((size_t)DEPTH * 4096 * 1024 * 2);
constexpr size_t OFF_WGLU = OFF_WFF2 + AL((size_t)DEPTH * 4096 * 1024 * 2);
constexpr size_t OFF_XBUF = OFF_WGLU + AL((size_t)DEPTH * 256 * 256 * 2);
constexpr size_t OFF_MIX = OFF_XBUF + AL((size_t)NTOK * 1024 * 4);
constexpr size_t OFF_MOD = OFF_MIX + AL((size_t)NTOK * 1024 * 2);
constexpr size_t OFF_SMALL = OFF_MOD + AL((size_t)DEPTH * 3 * 6144 * 4);
constexpr size_t OFF_AB = OFF_SMALL + 256;
constexpr size_t OFF_AT = OFF_AB + AL((size_t)DEPTH * 2 * 16 * 64 * 2 * 4);
constexpr size_t OFF_BBAR = OFF_AT + AL((size_t)DEPTH * 2 * 16 * 64 * 2 * 4);
constexpr size_t OFF_CM = OFF_BBAR + AL((size_t)DEPTH * 2 * 16 * 64 * 32 * 4);
constexpr size_t OFF_ROPE = OFF_CM + AL((size_t)DEPTH * 2 * 16 * 16 * 128 * 2);
constexpr size_t OFF_D128 = OFF_ROPE + AL((size_t)192 * 16 * 8);
constexpr size_t OFF_D64 = OFF_D128 + AL((size_t)256 * 128 * 2);
constexpr size_t OFF_TW = OFF_D64 + AL((size_t)128 * 128 * 2);
constexpr size_t OFF_WCS = OFF_TW + AL((size_t)128 * 64 * 8);
constexpr size_t OFF_R1 = OFF_WCS + AL((size_t)DEPTH * 4 * 64 * 128 * 2);
constexpr size_t OFF_HID = OFF_R1;
constexpr size_t OFF_Q = OFF_R1;
constexpr size_t OFF_QC = OFF_Q + AL((size_t)2 * 4 * 2 * 8192 * 64 * 2);
constexpr size_t OFF_K = OFF_QC + AL((size_t)2 * 4 * 2 * 256 * 64 * 2);
constexpr size_t OFF_VT = OFF_K + AL((size_t)2 * 4 * 2 * LK * 64 * 2);
constexpr size_t OFF_U = OFF_VT + AL((size_t)2 * 4 * LK * 128 * 2);
constexpr size_t OFF_F = OFF_U + AL((size_t)NTOK * 256 * 4);
constexpr size_t OFF_LOCAL = OFF_F + AL((size_t)NTOK * 256 * 4);
constexpr size_t OFF_CARRY = OFF_LOCAL + AL((size_t)2 * 2 * NCH * 1024 * 8);
constexpr size_t OFF_T = OFF_CARRY + AL((size_t)2 * 2 * NCH * 1024 * 8);
constexpr size_t OFF_HGLU = OFF_T + AL((size_t)2 * 4 * 128 * 2 * 64 * 64 * 4);
constexpr size_t OFF_END_MIX = OFF_HGLU + AL((size_t)NTOK * 256 * 2);
constexpr size_t OFF_END_HID = OFF_HID + AL((size_t)NTOK * 4096 * 2);
constexpr size_t OFF_XCTX2 = OFF_END_MIX > OFF_END_HID ? OFF_END_MIX : OFF_END_HID;
constexpr size_t OFF_HN = OFF_XCTX2 + AL((size_t)NBATCH * CTX * 1024 * 4);
constexpr size_t OFF_BAR = OFF_HN + AL((size_t)NTOK * 1024 * 2);
constexpr size_t BAR_BYTES = 3456 * 4;
constexpr size_t OFF_BBH = OFF_BAR + AL(BAR_BYTES);
constexpr size_t WS_NEED = OFF_BBH + AL((size_t)DEPTH * 2 * 16 * 128 * 16 * 2);

struct P {
  const float *x, *c, *ctx, *c_ctx, *w_mod, *b_mod, *g_norm1, *w_in, *g_qnorm, *g_knorm, *lam_q1, *lam_k1, *lam_q2, *lam_k2,
      *g_subln, *ssm_a_re, *ssm_a_im, *ssm_log_dt, *ssm_b_re, *ssm_b_im, *ssm_c_re, *ssm_c_im, *ssm_d, *w_glu, *b_glu, *w_fnet,
      *w_out, *g_norm2, *w_ff1, *w_ff2;
  float* out;
  char* ws;
};

DI unsigned pk2(float a, float b) { f32v2 v = {a, b}; return __builtin_bit_cast(unsigned, __builtin_convertvector(v, bf16v2)); }
DI u16 bf1(float a) { return (u16)(pk2(a, 0.f) & 0xffffu); }
DI float bf2f(u16 h) { return __uint_as_float(((unsigned)h) << 16); }
DI f32x4 mfma16(bf16x8 a, bf16x8 b, f32x4 c) { return __builtin_amdgcn_mfma_f32_16x16x32_bf16(a, b, c, 0, 0, 0); }
DI f32x16 mfma32(bf16x8 a, bf16x8 b, f32x16 c) { return __builtin_amdgcn_mfma_f32_32x32x16_bf16(a, b, c, 0, 0, 0); }
DI float silu(float v) { return v / (1.f + __expf(-v)); }
DI float gelu_tanh(float v) { float t = 0.7978845608028654f * (v + 0.044715f * v * v * v); return 0.5f * v * (1.f + tanhf(t)); }
DI int get_tid() { int t = threadIdx.x & 255; asm volatile("" : "+v"(t)); return t; }
DI void opaque_zero2(float& a, float& b) { asm volatile("v_mov_b32 %0, 0\n\tv_mov_b32 %1, 0" : "=v"(a), "=v"(b)); }
DI float* xa_tile(const P& p, int mt) { return (float*)(p.ws + OFF_XBUF) + (size_t)mt * 128 * 1024; }
DI const float* xa_rd_tile(const P& p, int layer, int mt) {
  if (layer == 0) return mt < 128 ? p.x + (size_t)mt * 128 * 1024 : p.ctx + (size_t)(mt - 128) * 128 * 1024;
  return (const float*)(p.ws + OFF_XBUF) + (size_t)mt * 128 * 1024;
}
DI float* xb_tile(const P& p, int mt) { return mt < 128 ? p.out + (size_t)mt * 128 * 1024 : (float*)(p.ws + OFF_XCTX2) + (size_t)(mt - 128) * 128 * 1024; }
DI float lam_init_of(int layer) { return 0.8f - 0.6f * expf(-0.3f * (float)layer); }

DI void tr_unit(const float* __restrict__ src, u16* __restrict__ dst, int K, int N, int u, char* smem) {
  float* t = (float*)smem;
  const int tid = get_tid();
  const int tnN = N / 64, tk = u / tnN, tn = u % tnN;
  __syncthreads();
#pragma unroll
  for (int i = 0; i < 4; ++i) {
    const int k = (tid >> 4) + 16 * i, n4 = (tid & 15) * 4;
    *(float4*)(t + k * 68 + n4) = *(const float4*)(src + (size_t)(tk * 64 + k) * N + tn * 64 + n4);
  }
  __syncthreads();
#pragma unroll
  for (int i = 0; i < 2; ++i) {
    const int item = tid + 256 * i, n = item >> 3, kb = (item & 7) * 8;
    const float* tp = t + kb * 68 + n;
    uint4 o;
    o.x = pk2(tp[0], tp[68]); o.y = pk2(tp[2 * 68], tp[3 * 68]); o.z = pk2(tp[4 * 68], tp[5 * 68]); o.w = pk2(tp[6 * 68], tp[7 * 68]);
    *(uint4*)(dst + (size_t)(tn * 64 + n) * K + tk * 64 + kb) = o;
  }
}

DI void prep_transposes(const P& p, int u, char* smem) {
  const int l = u / 2832; int r = u % 2832;
  char* ws = p.ws;
  if (r < 512) { tr_unit(p.w_in + (size_t)l * 1024 * 2048, (u16*)(ws + OFF_WIN) + (size_t)l * 2048 * 1024, 1024, 2048, r, smem); return; }
  r -= 512;
  if (r < 256) { tr_unit(p.w_out + (size_t)l * 1024 * 1024, (u16*)(ws + OFF_WOUT) + (size_t)l * 1024 * 1024, 1024, 1024, r, smem); return; }
  r -= 256;
  if (r < 1024) { tr_unit(p.w_ff1 + (size_t)l * 1024 * 4096, (u16*)(ws + OFF_WFF1) + (size_t)l * 4096 * 1024, 1024, 4096, r, smem); return; }
  r -= 1024;
  if (r < 1024) { tr_unit(p.w_ff2 + (size_t)l * 4096 * 1024, (u16*)(ws + OFF_WFF2) + (size_t)l * 1024 * 4096, 4096, 1024, r, smem); return; }
  r -= 1024;
  tr_unit(p.w_glu + (size_t)l * 256 * 256, (u16*)(ws + OFF_WGLU) + (size_t)l * 256 * 256, 256, 256, r, smem);
}

DI void prep_copy(const P& p, int u) {
  float4* dst = (float4*)(p.ws + OFF_XBUF);
  const float4* sx = (const float4*)p.x; const float4* sc = (const float4*)p.ctx;
  const size_t nx4 = (size_t)XTOK * 256;
const int tid = get_tid();
#pragma unroll 4
  for (int i = 0; i < 16; ++i) {
    const size_t idx = (size_t)u * 4096 + i * 256 + tid;
    dst[idx] = idx < nx4 ? sx[idx] : sc[idx - nx4];
  }
}

DI void prep_mod(const P& p, int u, char* smem) {
  float* act = (float*)smem;
  float* red = act + 3072;
  const int tid = get_tid();
  const int l = u / 96, jb = u % 96;
  __syncthreads();
  for (int i = tid; i < 3072; i += 256) {
    const int r = i >> 10, k = i & 1023;
    const float v = r < 2 ? p.c[r * 1024 + k] : p.c_ctx[k];
    act[i] = silu(v);
  }
  __syncthreads();
  const int j = jb * 64 + (tid & 63), kg = tid >> 6;
  float a0 = 0.f, a1 = 0.f, a2 = 0.f;
  const float* wp = p.w_mod + (size_t)l * 1024 * 6144 + j;
#pragma unroll 32
  for (int k = kg * 256; k < kg * 256 + 256; ++k) {
    const float wv = wp[(size_t)k * 6144];
    a0 += act[k] * wv; a1 += act[1024 + k] * wv; a2 += act[2048 + k] * wv;
  }
  red[(kg * 3 + 0) * 64 + (tid & 63)] = a0; red[(kg * 3 + 1) * 64 + (tid & 63)] = a1; red[(kg * 3 + 2) * 64 + (tid & 63)] = a2;
  __syncthreads();
  if (tid < 192) {
    const int r = tid >> 6, jj = tid & 63;
    float s = p.b_mod[l * 6144 + jb * 64 + jj];
    for (int q = 0; q < 4; ++q) s += red[(q * 3 + r) * 64 + jj];
    ((float*)(p.ws + OFF_MOD))[((size_t)l * 3 + r) * 6144 + jb * 64 + jj] = s;
  }
}

DI void prep_disc(const P& p, int u) {
  const int idx = u * 256 + get_tid();
  const int g = (idx >> 6) & 15;
  const int ld = idx >> 10;
  const float are = p.ssm_a_re[idx], aim = p.ssm_a_im[idx];
  const float dt = expf(p.ssm_log_dt[ld * 16 + g]);
  const float mag = expf(dt * are);
  const float abr = mag * cosf(dt * aim), abi = mag * sinf(dt * aim);
  const float den = are * are + aim * aim, nre = abr - 1.f;
  const float fre = (nre * are + abi * aim) / den, fim = (abi * are - nre * aim) / den;
  float2* AB = (float2*)(p.ws + OFF_AB); float2* AT = (float2*)(p.ws + OFF_AT);
  AB[idx] = make_float2(abr, abi);
  float tr = abr, ti = abi;
#pragma unroll
  for (int i = 0; i < 5; ++i) { const float nr = tr * tr - ti * ti, ni = 2.f * tr * ti; tr = nr; ti = ni; }
  AT[idx] = make_float2(tr, ti);
  float* bb = (float*)(p.ws + OFF_BBAR) + (size_t)idx * 32;
  const float* bre = p.ssm_b_re + (size_t)idx * 16; const float* bim = p.ssm_b_im + (size_t)idx * 16;
  for (int q = 0; q < 16; ++q) {
    const float br = bre[q], bi = bim[q];
    bb[q] = fre * br - fim * bi; bb[16 + q] = fre * bi + fim * br;
    u16* bh = (u16*)(p.ws + OFF_BBH) + ((size_t)(ld * 16 + g) * 128 + 2 * (idx & 63)) * 16;
    bh[q] = bf1(fre * br - fim * bi); bh[16 + q] = bf1(fre * bi + fim * br);
  }
}

DI void prep_tables(const P& p, int u) {
  const int i = u * 256 + get_tid();
  const float TWO_PI = 6.283185307179586f;
  char* ws = p.ws;
  if (i < 3072) {
    const int pos = i >> 4, j = i & 15;
    const float inv = powf(10000.f, -(float)j / 16.f);
    const float ang = (float)(pos < 128 ? pos : pos - 128) * inv;
    ((float2*)(ws + OFF_ROPE))[i] = make_float2(cosf(ang), sinf(ang));
    return;
  }
  int r = i - 3072;
  if (r < 32768) {
    const int row = r >> 7, rr = r & 127, ri = row >> 7, k1 = row & 127;
    const float ang = TWO_PI * (float)((k1 * rr) & 127) / 128.f;
    ((u16*)(ws + OFF_D128))[r] = bf1(ri == 0 ? cosf(ang) : -sinf(ang));
    return;
  }
  r -= 32768;
  if (r < 16384) {
    const int row = r >> 7, kx = r & 127, ri = row >> 6, k2 = row & 63, xri = kx >> 6, col = kx & 63;
    const float ang = TWO_PI * (float)((k2 * col) & 63) / 64.f;
    const float cr = cosf(ang), sr = sinf(ang);
    const float v = ri == 0 ? (xri == 0 ? cr : sr) : (xri == 0 ? -sr : cr);
    ((u16*)(ws + OFF_D64))[r] = bf1(v);
    return;
  }
  r -= 16384;
  if (r < 8192) {
    const int k1 = r >> 6, col = r & 63;
    const float ang = TWO_PI * (float)(k1 * col) / 8192.f;
    ((float2*)(ws + OFF_TW))[r] = make_float2(cosf(ang), -sinf(ang));
    return;
  }
  r -= 8192;
  if (r < DEPTH) {
    const int l = r;
    float s1 = 0.f, s2 = 0.f, gq = 0.f, gk = 0.f;
    for (int q = 0; q < 64; ++q) {
      s1 += p.lam_q1[l * 64 + q] * p.lam_k1[l * 64 + q]; s2 += p.lam_q2[l * 64 + q] * p.lam_k2[l * 64 + q];
      gq = fmaxf(gq, fabsf(p.g_qnorm[l * 64 + q])); gk = fmaxf(gk, fabsf(p.g_knorm[l * 64 + q]));
    }
    float* sm = (float*)(ws + OFF_SMALL);
    sm[l] = expf(s1) - expf(s2) + lam_init_of(l);
    sm[4 + l] = 8.f * gq * gk * LOG2E;
  }
}
constexpr int N_TABLE_UNITS = (3072 + 32768 + 16384 + 8192 + DEPTH + 255) / 256;

DI void prep_wcs(const P& p, int u) {
  const int idx = u * 256 + get_tid();
  const int k = idx & 127, d = (idx >> 7) & 63, lg = idx >> 13;
  const int ri = k >> 6, c = k & 63;
  const float* wf = p.w_fnet + (size_t)lg * 4096;
  float s = 0.f;
  for (int cp = 0; cp < 64; ++cp) {
    const float ang = 6.283185307179586f * (float)((c * cp) & 63) / 64.f;
    s += (ri == 0 ? cosf(ang) : sinf(ang)) * wf[cp * 64 + d];
  }
  ((u16*)(p.ws + OFF_WCS))[idx] = bf1(s * (1.f / 724.0773439350247f));
}

DI void prep_cm(const P& p, int u) {
  const int idx = u * 256 + get_tid();
  const int k = idx & 127, row = idx >> 7;
  const float v = k < 64 ? p.ssm_c_re[(size_t)row * 64 + k] : -p.ssm_c_im[(size_t)row * 64 + (k - 64)];
  ((u16*)(p.ws + OFF_CM))[idx] = bf1(v);
}


DI void norm_unit(const P& p, int layer, int which, int u) {
  const int tid = get_tid(), lane = tid & 63;
  const int r = u * 8 + (tid >> 6);
  const int mt = r >> 7;
  const float* xrow = (which == 0 ? xa_rd_tile(p, layer, mt) : (const float*)xb_tile(p, mt)) + (size_t)(r & 127) * 1024 + lane * 4;
  const float* modl = (const float*)(p.ws + OFF_MOD) + ((size_t)layer * 3 + (r < XTOK ? (r >> 13) : 2)) * 6144 + lane * 4;
  const float* sh = modl + (which == 0 ? 0 : 3072);
  const float* sc = modl + (which == 0 ? 1024 : 4096);
  const float* gn = (which == 0 ? p.g_norm1 : p.g_norm2) + layer * 1024 + lane * 4;
  const float4 v0 = *(const float4*)(xrow), v1 = *(const float4*)(xrow + 256), v2 = *(const float4*)(xrow + 512), v3 = *(const float4*)(xrow + 768);
  const float4 w0 = *(const float4*)(xrow + 4096), w1 = *(const float4*)(xrow + 4096 + 256), w2 = *(const float4*)(xrow + 4096 + 512), w3 = *(const float4*)(xrow + 4096 + 768);
  float4 g0 = *(const float4*)(gn), g1 = *(const float4*)(gn + 256), g2 = *(const float4*)(gn + 512), g3 = *(const float4*)(gn + 768);
  const float4 s0 = *(const float4*)(sc), s1 = *(const float4*)(sc + 256), s2 = *(const float4*)(sc + 512), s3 = *(const float4*)(sc + 768);
  const float4 h0 = *(const float4*)(sh), h1 = *(const float4*)(sh + 256), h2 = *(const float4*)(sh + 512), h3 = *(const float4*)(sh + 768);
#define SSQ4(V) (V.x * V.x + V.y * V.y + V.z * V.z + V.w * V.w)
  float ssa = SSQ4(v0) + SSQ4(v1) + SSQ4(v2) + SSQ4(v3), ssb = SSQ4(w0) + SSQ4(w1) + SSQ4(w2) + SSQ4(w3);
#undef SSQ4
#pragma unroll
  for (int o = 1; o < 64; o <<= 1) { ssa += __shfl_xor(ssa, o); ssb += __shfl_xor(ssb, o); }
  const float ra = rsqrtf(ssa * (1.f / 1024.f) + EPS), rb = rsqrtf(ssb * (1.f / 1024.f) + EPS);
  g0.x *= 1.f + s0.x; g0.y *= 1.f + s0.y; g0.z *= 1.f + s0.z; g0.w *= 1.f + s0.w;
  g1.x *= 1.f + s1.x; g1.y *= 1.f + s1.y; g1.z *= 1.f + s1.z; g1.w *= 1.f + s1.w;
  g2.x *= 1.f + s2.x; g2.y *= 1.f + s2.y; g2.z *= 1.f + s2.z; g2.w *= 1.f + s2.w;
  g3.x *= 1.f + s3.x; g3.y *= 1.f + s3.y; g3.z *= 1.f + s3.z; g3.w *= 1.f + s3.w;
  u16* dst = (u16*)(p.ws + OFF_HN) + (size_t)r * 1024 + lane * 4;
#define NORM_ST(V, RS, Gv, Hv, OFS) do { uint2 o; \
    o.x = pk2(V.x * RS * Gv.x + Hv.x, V.y * RS * Gv.y + Hv.y); \
    o.y = pk2(V.z * RS * Gv.z + Hv.z, V.w * RS * Gv.w + Hv.w); \
    *(uint2*)(dst + (OFS)) = o; } while (0)
  NORM_ST(v0, ra, g0, h0, 0); NORM_ST(v1, ra, g1, h1, 256); NORM_ST(v2, ra, g2, h2, 512); NORM_ST(v3, ra, g3, h3, 768);
  NORM_ST(w0, rb, g0, h0, 4096); NORM_ST(w1, rb, g1, h1, 4096 + 256); NORM_ST(w2, rb, g2, h2, 4096 + 512); NORM_ST(w3, rb, g3, h3, 4096 + 768);
#undef NORM_ST
}

enum { EPI_PROJ = 0, EPI_OUT = 1, EPI_FF1 = 2, EPI_FF2 = 3, EPI_GLU = 4 };
constexpr int LDT = 72;

template <int AMODE, int EPI>
DI void gemm_unit(const P& p, int layer, int mt, int nt, int K, const u16* __restrict__ Wt, const void* __restrict__ Asrc, int lda,
                  const float* gn, const float* sc, const float* sh, char* smem, bool dup, int role = -1, char* smem_other = nullptr) {
  const int tid = get_tid(), lane = tid & 63, w = tid >> 6, wr = w >> 1, wc = w & 1, fr = lane & 15, fq = lane >> 4;
  u16* As = (u16*)smem;
  u16* Bs = As + 2 * 128 * LDT;
  float* rs = (float*)(Bs + 2 * 128 * LDT);
  const int rmod = mt < 128 ? (mt >> 6) : 2;
  const float* modl = (const float*)(p.ws + OFF_MOD) + ((size_t)layer * 3 + rmod) * 6144;
  __syncthreads();
  f32x4 acc[4][4];
#pragma unroll
  for (int m = 0; m < 4; ++m)
#pragma unroll
    for (int n = 0; n < 4; ++n) acc[m][n] = (f32x4){0.f, 0.f, 0.f, 0.f};

  uint4 p0, p1, p2, p3, q0, q1, q2, q3;
  uint4 r0, r1, r2, r3, t0, t1, t2, t3;
  uint4 x0, x1, x2, x3, z0, z1, z2, z3;
  const int nk = role > 0 ? K / 128 : K / 64;
  const int kofs = role == 2 ? K / 2 : 0;
  const bool share = role == 0;
  const bool hi = share && smem_other < smem;
  const u16* Ag = (const u16*)Asrc + (size_t)(mt * 128 + (share && hi ? 64 : 0) + (tid >> 3)) * lda + (tid & 7) * 8 + kofs;
  const u16* afb = share ? ((wr == (hi ? 1 : 0)) ? As : (const u16*)smem_other) : As + wr * 64 * LDT;
  const u16* Bg = Wt + (size_t)(nt * 128 + (tid >> 3)) * K + (tid & 7) * 8 + kofs;
  const int lrow = ((tid >> 3)) * LDT + (tid & 7) * 8;
#define GLOAD(A0, A1, A2, A3, B0, B1, B2, B3, kt)                                                 \
  do {                                                                                            \
    B0 = *(const uint4*)(Bg + (kt) * 64); B1 = *(const uint4*)(Bg + (size_t)32 * K + (kt) * 64);  \
    B2 = *(const uint4*)(Bg + (size_t)64 * K + (kt) * 64); B3 = *(const uint4*)(Bg + (size_t)96 * K + (kt) * 64); \
    A0 = *(const uint4*)(Ag + (kt) * 64); A1 = *(const uint4*)(Ag + (size_t)32 * lda + (kt) * 64); \
    if (!share) { A2 = *(const uint4*)(Ag + (size_t)64 * lda + (kt) * 64); A3 = *(const uint4*)(Ag + (size_t)96 * lda + (kt) * 64); } \
  } while (0)
#define LSTORE(A0, A1, A2, A3, B0, B1, B2, B3, buf)                                               \
  do {                                                                                            \
    u16* bs_ = Bs + (buf) * 128 * LDT + lrow; u16* as_ = As + (buf) * 128 * LDT + lrow;          \
    *(uint4*)(bs_) = B0; *(uint4*)(bs_ + 32 * LDT) = B1; *(uint4*)(bs_ + 64 * LDT) = B2; *(uint4*)(bs_ + 96 * LDT) = B3; \
    *(uint4*)(as_) = A0; *(uint4*)(as_ + 32 * LDT) = A1; if (!share) { *(uint4*)(as_ + 64 * LDT) = A2; *(uint4*)(as_ + 96 * LDT) = A3; } \
  } while (0)
#define ST0 p0, p1, p2, p3, q0, q1, q2, q3
#define ST1 r0, r1, r2, r3, t0, t1, t2, t3
#define ST2 x0, x1, x2, x3, z0, z1, z2, z3
#define GLOAD_(...) GLOAD(__VA_ARGS__)
#define LSTORE_(...) LSTORE(__VA_ARGS__)
#define COMPUTE(buf)                                                                              \
  do {                                                                                            \
    _Pragma("unroll") for (int kk = 0; kk < 2; ++kk) {                                            \
      bf16x8 af[4], wf[4];                                                                        \
      _Pragma("unroll") for (int m = 0; m < 4; ++m) af[m] = *(const bf16x8*)(afb + (buf) * 128 * LDT + (m * 16 + fr) * LDT + kk * 32 + fq * 8); \
      _Pragma("unroll") for (int n = 0; n < 4; ++n) wf[n] = *(const bf16x8*)(Bs + (buf) * 128 * LDT + (wc * 64 + n * 16 + fr) * LDT + kk * 32 + fq * 8); \
      _Pragma("unroll") for (int m = 0; m < 4; ++m)                                               \
        _Pragma("unroll") for (int n = 0; n < 4; ++n) acc[m][n] = mfma16(wf[n], af[m], acc[m][n]); \
    }                                                                                             \
  } while (0)

#define STEP(SL, SS, buf, i)                                          \
  if (kt + (i) < nk) {                                                \
    if (kt + (i) + 3 < nk) GLOAD_(SL, kt + (i) + 3);                  \
    COMPUTE(buf);                                                     \
    if (kt + (i) + 1 < nk) LSTORE_(SS, (buf) ^ 1);                    \
    __syncthreads();                                                  \
  }
  GLOAD_(ST0, 0);
  GLOAD_(ST1, 1);
  if (nk > 2) GLOAD_(ST2, 2);
  LSTORE_(ST0, 0);
  __syncthreads();
  for (int kt = 0; kt < nk; kt += 6) {
    STEP(ST0, ST1, 0, 0)
    STEP(ST1, ST2, 1, 1)
    STEP(ST2, ST0, 0, 2)
    STEP(ST0, ST1, 1, 3)
    STEP(ST1, ST2, 0, 4)
    STEP(ST2, ST0, 1, 5)
  }
#undef STEP
#undef GLOAD
#undef LSTORE
#undef COMPUTE
#undef ST0
#undef ST1
#undef ST2
#undef GLOAD_
#undef LSTORE_
  if (role > 0) {
    if (role == 2) {
#pragma unroll
      for (int m = 0; m < 4; ++m)
#pragma unroll
        for (int n = 0; n < 4; ++n) *(f32x4*)(smem + ((size_t)((m * 4 + n) * 256 + tid)) * 16) = acc[m][n];
    }
    __syncthreads();
    if (role == 2) return;
#pragma unroll
    for (int m = 0; m < 4; ++m)
#pragma unroll
      for (int n = 0; n < 4; ++n) acc[m][n] = acc[m][n] + *(const f32x4*)(smem_other + ((size_t)((m * 4 + n) * 256 + tid)) * 16);
  }

  if (dup) return;
  const int tok0 = mt * 128 + wr * 64 + fr;
  const int f0 = nt * 128 + wc * 64 + fq * 4;
  char* ws = p.ws;
  if (EPI == EPI_PROJ) {
    const bool isctx = mt >= 128;
    if (nt < 8) {
      const int grp = nt * 2 + wc; const bool isK = grp >= 8; const int gi = grp & 7, hh = gi >> 1, mp = gi & 1;
      const float* gw = (isK ? p.g_knorm : p.g_qnorm) + layer * 64;
      float gwv[4][4];
#pragma unroll
      for (int n = 0; n < 4; ++n) { const float4 t = *(const float4*)(gw + n * 16 + fq * 4); gwv[n][0] = t.x; gwv[n][1] = t.y; gwv[n][2] = t.z; gwv[n][3] = t.w; }
      const float2* rope = (const float2*)(ws + OFF_ROPE);
      const float osc = isK ? 1.f : 0.125f * LOG2E;
#pragma unroll
      for (int m = 0; m < 4; ++m) {
        const int tok = tok0 + m * 16;
        float ss = 0.f;
#pragma unroll
        for (int n = 0; n < 4; ++n)
#pragma unroll
          for (int j = 0; j < 4; ++j) ss += acc[m][n][j] * acc[m][n][j];
        ss += __shfl_xor(ss, 16); ss += __shfl_xor(ss, 32);
        const float rstd = rsqrtf(ss * (1.f / 64.f) + EPS);
        float v[4][4];
#pragma unroll
        for (int n = 0; n < 4; ++n)
#pragma unroll
          for (int j = 0; j < 4; ++j) v[n][j] = acc[m][n][j] * rstd * gwv[n][j];
        u16* dst;
        if (!isctx) {
          const int b = tok >> 13, t = tok & 8191, prow = t >> 6, pcol = t & 63;
#pragma unroll
          for (int n = 0; n < 2; ++n) {
            const float2* rp = rope + (size_t)(n == 0 ? prow : 128 + pcol) * 16 + fq * 4;
#pragma unroll
            for (int j = 0; j < 4; ++j) {
              const float2 cs = rp[j];
              const float x1 = v[n][j], x2 = v[n + 2][j];
              v[n][j] = x1 * cs.x - x2 * cs.y; v[n + 2][j] = x2 * cs.x + x1 * cs.y;
            }
          }
          if (isK) dst = (u16*)(ws + OFF_K) + ((size_t)((b * 4 + hh) * 2 + mp) * LK + 256 + t) * 64;
          else dst = (u16*)(ws + OFF_Q) + ((size_t)((b * 4 + hh) * 2 + mp) * 8192 + t) * 64;
        } else {
          const int tc = tok - XTOK, b = tc >> 8, t = tc & 255;
          if (isK) dst = (u16*)(ws + OFF_K) + ((size_t)((b * 4 + hh) * 2 + mp) * LK + t) * 64;
          else dst = (u16*)(ws + OFF_QC) + ((size_t)((b * 4 + hh) * 2 + mp) * 256 + t) * 64;
        }
#pragma unroll
        for (int n = 0; n < 4; ++n) {
          uint2 o; o.x = pk2(v[n][0] * osc, v[n][1] * osc); o.y = pk2(v[n][2] * osc, v[n][3] * osc);
          *(uint2*)(dst + n * 16 + fq * 4) = o;
        }
      }
    } else if (nt < 12) {
      const int hh = nt - 8;
      u16* vt = (u16*)(ws + OFF_VT);
#pragma unroll
      for (int m = 0; m < 4; ++m) {
        const int tok = tok0 + m * 16;
        int b, key;
        if (!isctx) { b = tok >> 13; key = 256 + (tok & 8191); } else { const int tc = tok - XTOK; b = tc >> 8; key = tc & 255; }
        const size_t base = ((size_t)(b * 4 + hh) * NKT + (key >> 5)) * 128 * 32 + (key & 31);
#pragma unroll
        for (int n = 0; n < 4; ++n)
#pragma unroll
          for (int j = 0; j < 4; ++j) { const int dv = wc * 64 + n * 16 + fq * 4 + j; vt[base + (size_t)dv * 32] = bf1(acc[m][n][j]); }
      }
    } else {
      float* dstb = (float*)(ws + (nt < 14 ? OFF_U : OFF_F));
      const int c0 = (nt & 1) * 128 + wc * 64 + fq * 4;
#pragma unroll
      for (int m = 0; m < 4; ++m) {
        const int tok = tok0 + m * 16;
#pragma unroll
        for (int n = 0; n < 4; ++n) *(f32x4*)(dstb + (size_t)tok * 256 + c0 + n * 16) = acc[m][n];
      }
    }
  } else if (EPI == EPI_OUT || EPI == EPI_FF2) {
    const float* gate = modl + (EPI == EPI_OUT ? 2048 : 5120);
    const bool last = (EPI == EPI_FF2) && (layer == DEPTH - 1);
    const float* xin = (EPI == EPI_OUT) ? xa_rd_tile(p, layer, mt) : (const float*)xb_tile(p, mt);
    float* xout = (EPI == EPI_OUT || last) ? xb_tile(p, mt) : xa_tile(p, mt);
#pragma unroll
    for (int m = 0; m < 4; ++m) {
      const int lrow = wr * 64 + m * 16 + fr;
#pragma unroll
      for (int n = 0; n < 4; ++n) {
        const int f = f0 + n * 16;
        const f32x4 gv = *(const f32x4*)(gate + f);
        f32x4 xv = *(const f32x4*)(xin + (size_t)lrow * 1024 + f);
        xv = xv + gv * acc[m][n];
        *(f32x4*)(xout + (size_t)lrow * 1024 + f) = xv;
      }
    }
  } else if (EPI == EPI_FF1) {
    u16* hid = (u16*)(ws + OFF_HID);
#pragma unroll
    for (int m = 0; m < 4; ++m) {
      const int tok = tok0 + m * 16;
#pragma unroll
      for (int n = 0; n < 4; ++n) {
        f32x4 a = acc[m][n];
#pragma unroll
        for (int j = 0; j < 4; ++j) { const float r = fmaxf(a[j], 0.f); a[j] = r * r; }
        uint2 o; o.x = pk2(a[0], a[1]); o.y = pk2(a[2], a[3]);
        *(uint2*)(hid + (size_t)tok * DFF + f0 + n * 16) = o;
      }
    }
  } else if (EPI == EPI_GLU) {
    const u16* hg = (const u16*)(ws + OFF_HGLU);
    u16* mix = (u16*)(ws + OFF_MIX);
    const float* bg = p.b_glu + layer * 256;
#pragma unroll
    for (int m = 0; m < 4; ++m) {
      const int tok = tok0 + m * 16;
#pragma unroll
      for (int n = 0; n < 4; ++n) {
        const int f = f0 + n * 16;
        const uint2 hv = *(const uint2*)(hg + (size_t)tok * 256 + f);
        const f32x4 bv = *(const f32x4*)(bg + f);
        float h[4] = {bf2f((u16)(hv.x & 0xffff)), bf2f((u16)(hv.x >> 16)), bf2f((u16)(hv.y & 0xffff)), bf2f((u16)(hv.y >> 16))};
        float o[4];
#pragma unroll
        for (int j = 0; j < 4; ++j) { const float z = acc[m][n][j] + bv[j]; o[j] = h[j] / (1.f + __expf(-z)); }
        uint2 ov; ov.x = pk2(o[0], o[1]); ov.y = pk2(o[2], o[3]);
        *(uint2*)(mix + (size_t)tok * 1024 + 512 + f) = ov;
      }
    }
  }
}

DI void attn_unit(const P& p, int layer, int u, char* smem, char* smem_o) {
  const int tid = get_tid(), lane = tid & 63, w = tid >> 6, l32 = lane & 31, hf = lane >> 5;
  char* ws = p.ws;
  int b, hh, qb, nkt, lq; const u16* Qsrc; int tokbase;
  if (u < 512) { b = u >> 8; hh = (u >> 6) & 3; qb = u & 63; nkt = NKT; lq = 8192; Qsrc = (const u16*)(ws + OFF_Q); tokbase = b * 8192 + qb * 128; }
  else { const int uu = u - 512; b = uu >> 3; hh = (uu >> 1) & 3; qb = uu & 1; nkt = 8; lq = 256; Qsrc = (const u16*)(ws + OFF_QC); tokbase = XTOK + b * 256 + qb * 128; }
  const u16* Q0 = Qsrc + ((size_t)((b * 4 + hh) * 2) * lq + qb * 128) * 64;
  const u16* K0 = (const u16*)(ws + OFF_K) + (size_t)((b * 4 + hh) * 2) * LK * 64;
  const u16* V0 = (const u16*)(ws + OFF_VT) + (size_t)(b * 4 + hh) * NKT * 4096;
  u16* Qs = (u16*)smem;
  u16* KV = Qs + 2 * 128 * LDT;
  constexpr int KVSTRIDE = 32 * LDT + 64 * 40;
  const bool hi = smem_o < smem;
  const u16* KVo = (const u16*)smem_o + 2 * 128 * LDT;
  const u16* kbase0 = hi ? KVo : KV;
  const u16* kbase1 = hi ? KV : KVo;
  const float lam = ((const float*)(ws + OFF_SMALL))[layer];
  __syncthreads();
#pragma unroll
  for (int i = 0; i < 8; ++i) {
    const int pi = tid + 256 * i;
    const int mp = pi >> 10, row = (pi >> 3) & 127, seg = pi & 7;
    *(uint4*)(Qs + (mp * 128 + row) * LDT + seg * 8) = *(const uint4*)(Q0 + (size_t)mp * lq * 64 + row * 64 + seg * 8);
  }
  uint4 kr0, vr0;
#define AGLOAD(kt)                                                                         \
  do {                                                                                     \
    kr0 = *(const uint4*)(K0 + (hi ? (size_t)LK * 64 : (size_t)0) + (size_t)(kt) * 2048 + tid * 8); \
    vr0 = *(const uint4*)(V0 + (size_t)(kt) * 4096 + (hi ? 2048 : 0) + tid * 8);           \
  } while (0)
#define ALSTORE(buf)                                                                       \
  do {                                                                                     \
    u16* kb = KV + (buf) * KVSTRIDE;                                                       \
    *(uint4*)(kb + (tid >> 3) * LDT + (tid & 7) * 8) = kr0;                                \
    u16* vb = kb + 32 * LDT;                                                               \
    *(uint4*)(vb + (tid >> 2) * 40 + (tid & 3) * 8) = vr0;                                 \
  } while (0)
  AGLOAD(0);
  ALSTORE(0);
  __syncthreads();

  f32x16 o1[4], o2[4];
#pragma unroll
  for (int i = 0; i < 4; ++i)
#pragma unroll
    for (int j = 0; j < 16; ++j) { o1[i][j] = 0.f; o2[i][j] = 0.f; }
  float l1 = 0.f, l2 = 0.f;
  const u16* qrow = Qs + (w * 32 + l32) * LDT + hf * 8;

  const bf16x8 qa0 = *(const bf16x8*)(qrow), qa1 = *(const bf16x8*)(qrow + 16);
  for (int kt = 0; kt < nkt; ++kt) {
    const int buf = kt & 1;
    if (kt + 1 < nkt) AGLOAD(kt + 1);
    const u16* kb0 = kbase0 + buf * KVSTRIDE;
    const u16* kb1 = kbase1 + buf * KVSTRIDE;
    f32x16 s1, s2;
#pragma unroll
    for (int j = 0; j < 16; ++j) { s1[j] = 0.f; s2[j] = 0.f; }
#pragma unroll
    for (int kk = 0; kk < 4; ++kk) {
      const bf16x8 kf1 = *(const bf16x8*)(kb0 + l32 * LDT + kk * 16 + hf * 8);
      s1 = mfma32(kf1, kk == 0 ? qa0 : (kk == 1 ? qa1 : *(const bf16x8*)(qrow + kk * 16)), s1);
      const bf16x8 kf2 = *(const bf16x8*)(kb1 + l32 * LDT + kk * 16 + hf * 8);
      const bf16x8 qf2 = *(const bf16x8*)(qrow + 128 * LDT + kk * 16);
      s2 = mfma32(kf2, qf2, s2);
    }
    bf16x8 pf1[2], pf2[2];
    {
      unsigned pk[8], pq[8];
#pragma unroll
      for (int j = 0; j < 8; ++j) {
        const float a0 = __builtin_amdgcn_exp2f(s1[2 * j]), a1 = __builtin_amdgcn_exp2f(s1[2 * j + 1]);
        const float c0 = __builtin_amdgcn_exp2f(s2[2 * j]), c1 = __builtin_amdgcn_exp2f(s2[2 * j + 1]);
        l1 += a0 + a1; l2 += c0 + c1;
        pk[j] = pk2(a0, a1); pq[j] = pk2(c0, c1);
      }
      typedef unsigned u32x4 __attribute__((ext_vector_type(4)));
      pf1[0] = __builtin_bit_cast(bf16x8, (u32x4){pk[0], pk[1], pk[2], pk[3]});
      pf1[1] = __builtin_bit_cast(bf16x8, (u32x4){pk[4], pk[5], pk[6], pk[7]});
      pf2[0] = __builtin_bit_cast(bf16x8, (u32x4){pq[0], pq[1], pq[2], pq[3]});
      pf2[1] = __builtin_bit_cast(bf16x8, (u32x4){pq[4], pq[5], pq[6], pq[7]});
    }
#pragma unroll
    for (int blk = 0; blk < 4; ++blk) {
#pragma unroll
      for (int s = 0; s < 2; ++s) {
        const u16* vp = (blk < 2 ? kb0 : kb1) + 32 * LDT + ((blk & 1) * 32 + l32) * 40 + 16 * s + 4 * hf;
        const uint2 lo = *(const uint2*)vp, hi = *(const uint2*)(vp + 8);
        typedef unsigned u32x4 __attribute__((ext_vector_type(4)));
        const bf16x8 vf = __builtin_bit_cast(bf16x8, (u32x4){lo.x, lo.y, hi.x, hi.y});
        o1[blk] = mfma32(vf, pf1[s], o1[blk]);
        o2[blk] = mfma32(vf, pf2[s], o2[blk]);
      }
    }
    if (kt + 1 < nkt) ALSTORE(buf ^ 1);
    __syncthreads();
  }
#undef AGLOAD
#undef ALSTORE
  l1 += __shfl_xor(l1, 32); l2 += __shfl_xor(l2, 32);
  const float i1 = 1.f / l1, i2 = lam / l2;
  float ss = 0.f;
#pragma unroll
  for (int blk = 0; blk < 4; ++blk)
#pragma unroll
    for (int j = 0; j < 16; ++j) { const float v = o1[blk][j] * i1 - o2[blk][j] * i2; o1[blk][j] = v; ss += v * v; }
  ss += __shfl_xor(ss, 32);
  const float rstd = rsqrtf(ss * (1.f / 128.f) + EPS) * (1.f - lam_init_of(layer));
  const float* gs = p.g_subln + layer * 128;
  u16* mix = (u16*)(ws + OFF_MIX) + (size_t)(tokbase + w * 32 + l32) * 1024 + hh * 128;
#pragma unroll
  for (int blk = 0; blk < 4; ++blk)
#pragma unroll
    for (int g4 = 0; g4 < 4; ++g4) {
      const int dv = blk * 32 + 8 * g4 + 4 * hf;
      const float4 gv = *(const float4*)(gs + dv);
      uint2 o;
      o.x = pk2(o1[blk][4 * g4] * rstd * gv.x, o1[blk][4 * g4 + 1] * rstd * gv.y);
      o.y = pk2(o1[blk][4 * g4 + 2] * rstd * gv.z, o1[blk][4 * g4 + 3] * rstd * gv.w);
      *(uint2*)(mix + dv) = o;
    }
}

template <bool FINAL, bool HORNER>
DI void ssm_unit(const P& p, int layer, int b, int blk, char* smem) {
  const int tid = get_tid(), lane = tid & 63, w = tid >> 6, fr = lane & 15, fq = lane >> 4;
  char* ws = p.ws;
  int tok0, cf, cr;
  if (blk < 256) { tok0 = b * 8192 + blk * 32; cf = 8 + blk; cr = 8 + 255 - blk; }
  else { const int cb = blk - 256; tok0 = XTOK + b * 256 + cb * 32; cf = cb; cr = 7 - cb; }
  u16* ub = (u16*)smem;
  float* BUw = (float*)(smem + 16896) + w * 16 * 132;
  __syncthreads();
  {
    const float4* src = (const float4*)((const float*)(ws + OFF_U) + (size_t)tok0 * 256);
#pragma unroll
    for (int i = 0; i < 8; ++i) {
      const int e = tid + 256 * i, row = e >> 6, c4 = (e & 63) * 4;
      const float4 v = src[e];
      uint2 o; o.x = pk2(v.x, v.y); o.y = pk2(v.z, v.w);
      *(uint2*)(ub + row * 264 + c4) = o;
    }
  }
  __syncthreads();
  const float2* AB = (const float2*)(ws + OFF_AB);
  const u16* BBH = (const u16*)(ws + OFF_BBH);
  const u16* CM = (const u16*)(ws + OFF_CM);
  float2* LOC = (float2*)(ws + OFF_LOCAL);
  const float2* CAR = (const float2*)(ws + OFF_CARRY);
  const bf16x8 zero8 = {0, 0, 0, 0, 0, 0, 0, 0};
  for (int gi = 0; gi < 4; ++gi) {
    const int g = w * 4 + gi;
    f32x4 y0 = (f32x4){0.f, 0.f, 0.f, 0.f}, y1 = (f32x4){0.f, 0.f, 0.f, 0.f};
#pragma unroll
    for (int dir = 0; dir < 2; ++dir) {
      const int sidx = ((layer * 2 + dir) * 16 + g) * 64 + lane;
      const float2 a = AB[sidx];
      const int chunk = dir ? cr : cf;
      const size_t cidx = ((size_t)((b * 2 + dir) * NCH + chunk) * 16 + g) * 64 + lane;
      float sr, si;
      if (FINAL && !HORNER) { const float2 c0 = CAR[cidx]; sr = c0.x; si = c0.y; }
      else { opaque_zero2(sr, si); }
      if (FINAL && HORNER) {
        const float2 aT = ((const float2*)(ws + OFF_AT))[sidx];
        const float2* lp = LOC + ((size_t)((b * 2 + dir) * NCH) * 16 + g) * 64 + lane;
        for (int c = 0; c < chunk; ++c) {
          const float2 lo = lp[(size_t)c * 1024];
          const float nr = aT.x * sr - aT.y * si + lo.x, ni = aT.x * si + aT.y * sr + lo.y;
          sr = nr; si = ni;
        }
      }
      const u16* bbp = BBH + ((size_t)((layer * 2 + dir) * 16 + g) * 128 + fr) * 16 + (fq & 1) * 8;
      const u16* cmp = CM + ((size_t)((layer * 2 + dir) * 16 + g) * 16 + fr) * 128 + fq * 8;
      bf16x8 bfr0 = *(const bf16x8*)(bbp), bfr1 = *(const bf16x8*)(bbp + 256), bfr2 = *(const bf16x8*)(bbp + 512), bfr3 = *(const bf16x8*)(bbp + 768);
      bf16x8 bfr4 = *(const bf16x8*)(bbp + 1024), bfr5 = *(const bf16x8*)(bbp + 1280), bfr6 = *(const bf16x8*)(bbp + 1536), bfr7 = *(const bf16x8*)(bbp + 1792);
      if (fq >= 2) { bfr0 = zero8; bfr1 = zero8; bfr2 = zero8; bfr3 = zero8; bfr4 = zero8; bfr5 = zero8; bfr6 = zero8; bfr7 = zero8; }
      bf16x8 cf0 = zero8, cf1 = zero8, cf2 = zero8, cf3 = zero8;
      if (FINAL) { cf0 = *(const bf16x8*)(cmp); cf1 = *(const bf16x8*)(cmp + 32); cf2 = *(const bf16x8*)(cmp + 64); cf3 = *(const bf16x8*)(cmp + 96); }
#pragma unroll
      for (int hh = 0; hh < 2; ++hh) {
        const int tb = dir ? 1 - hh : hh;
        {
          const bf16x8 ufl = *(const bf16x8*)(ub + (tb * 16 + fr) * 264 + g * 16 + (fq & 1) * 8);
          const bf16x8 uf = fq < 2 ? ufl : zero8;
#define BU_(CBI, BF) do { const f32x4 d = mfma16(BF, uf, (f32x4){0.f, 0.f, 0.f, 0.f}); *(f32x4*)(BUw + fr * 132 + (CBI) * 16 + fq * 4) = d; } while (0)
          BU_(0, bfr0); BU_(1, bfr1); BU_(2, bfr2); BU_(3, bfr3); BU_(4, bfr4); BU_(5, bfr5); BU_(6, bfr6); BU_(7, bfr7);
#undef BU_
        }
        __syncthreads();
#pragma unroll 4
        for (int tt = 0; tt < 16; ++tt) {
          const int tl = dir ? 15 - tt : tt;
          const float2 bu = *(const float2*)(BUw + tl * 132 + 2 * lane);
          const float nr = a.x * sr - a.y * si + bu.x, ni = a.x * si + a.y * sr + bu.y;
          sr = nr; si = ni;
          if (FINAL) { u16* srow = (u16*)(BUw + tl * 132); srow[lane] = bf1(sr); srow[64 + lane] = bf1(si); }
        }
        __syncthreads();
        if (FINAL) {
          f32x4 yy = tb == 0 ? y0 : y1;
          const u16* sp = (const u16*)(BUw + fr * 132) + fq * 8;
          yy = mfma16(cf0, *(const bf16x8*)(sp), yy);
          yy = mfma16(cf1, *(const bf16x8*)(sp + 32), yy);
          yy = mfma16(cf2, *(const bf16x8*)(sp + 64), yy);
          yy = mfma16(cf3, *(const bf16x8*)(sp + 96), yy);
          if (tb == 0) y0 = yy; else y1 = yy;
          __syncthreads();
        }
      }
      if (!FINAL) LOC[cidx] = make_float2(sr, si);
    }
    if (FINAL) {
      const int ch = g * 16 + fq * 4;
      const float4 dsk = *(const float4*)(p.ssm_d + layer * 256 + ch);
      u16* hg = (u16*)(ws + OFF_HGLU);
#pragma unroll
      for (int tb = 0; tb < 2; ++tb) {
        const int t = tb * 16 + fr;
        const f32x4 yv = tb == 0 ? y0 : y1;
        const uint2 uraw = *(const uint2*)(ub + t * 264 + ch);
        const float u0 = bf2f((u16)(uraw.x & 0xffff)), u1 = bf2f((u16)(uraw.x >> 16)), u2 = bf2f((u16)(uraw.y & 0xffff)), u3 = bf2f((u16)(uraw.y >> 16));
        const float r0 = gelu_tanh(yv[0] + dsk.x * u0), r1 = gelu_tanh(yv[1] + dsk.y * u1);
        const float r2 = gelu_tanh(yv[2] + dsk.z * u2), r3 = gelu_tanh(yv[3] + dsk.w * u3);
        uint2 o; o.x = pk2(r0, r1); o.y = pk2(r2, r3);
        *(uint2*)(hg + (size_t)(tok0 + t) * 256 + ch) = o;
      }
    }
  }
}

DI void ssm_carry_unit(const P& p, int layer, int u, char* smem) {
  const int tid = get_tid(), seg = tid >> 5, sl = tid & 31;
  const int st = u * 32 + sl;
  const int gn = st & 1023, bd = st >> 10, dir = bd & 1;
  float2* tot = (float2*)smem;
  const float2 aT = ((const float2*)(p.ws + OFF_AT))[((layer * 2 + dir) * 1024) + gn];
  const float2* LOC = (const float2*)(p.ws + OFF_LOCAL) + (size_t)bd * NCH * 1024 + gn + (size_t)seg * 33 * 1024;
  float2* CAR = (float2*)(p.ws + OFF_CARRY) + (size_t)bd * NCH * 1024 + gn + (size_t)seg * 33 * 1024;
  __syncthreads();
  float sr, si;
  opaque_zero2(sr, si);
  float pr = 1.f, pi = 0.f;
#pragma unroll 11
  for (int j = 0; j < 33; ++j) {
    const float2 lo = LOC[(size_t)j * 1024];
    const float nr = aT.x * sr - aT.y * si + lo.x, ni = aT.x * si + aT.y * sr + lo.y;
    sr = nr; si = ni;
    const float qr = pr * aT.x - pi * aT.y, qi = pr * aT.y + pi * aT.x;
    pr = qr; pi = qi;
  }
  tot[seg * 32 + sl] = make_float2(sr, si);
  __syncthreads();
  opaque_zero2(sr, si);
  for (int k = 0; k < seg; ++k) {
    const float2 t = tot[k * 32 + sl];
    const float nr = pr * sr - pi * si + t.x, ni = pr * si + pi * sr + t.y;
    sr = nr; si = ni;
  }
#pragma unroll 11
  for (int j = 0; j < 33; ++j) {
    CAR[(size_t)j * 1024] = make_float2(sr, si);
    const float2 lo = LOC[(size_t)j * 1024];
    const float nr = aT.x * sr - aT.y * si + lo.x, ni = aT.x * si + aT.y * sr + lo.y;
    sr = nr; si = ni;
  }
}

DI void fft1_unit(const P& p, int u, char* smem) {
  const int tid = get_tid(), lane = tid & 63, w = tid >> 6, fr = lane & 15, fq = lane >> 4;
  const int b = u >> 8, col = (u >> 2) & 63, g = u & 3;
  u16* Ht = (u16*)smem;
  __syncthreads();
  const float* F = (const float*)(p.ws + OFF_F);
#pragma unroll
  for (int i = 0; i < 8; ++i) {
    const int r = (tid >> 4) + 16 * i, c4 = (tid & 15) * 4;
    const float4 v = *(const float4*)(F + (size_t)(b * 8192 + 64 * r + col) * 256 + g * 64 + c4);
    Ht[(c4 + 0) * 136 + r] = bf1(v.x); Ht[(c4 + 1) * 136 + r] = bf1(v.y); Ht[(c4 + 2) * 136 + r] = bf1(v.z); Ht[(c4 + 3) * 136 + r] = bf1(v.w);
  }
  __syncthreads();
  f32x4 acc[4][4];
#pragma unroll
  for (int n = 0; n < 4; ++n)
#pragma unroll
    for (int m = 0; m < 4; ++m) acc[n][m] = (f32x4){0.f, 0.f, 0.f, 0.f};
  const u16* D = (const u16*)(p.ws + OFF_D128);
#pragma unroll
  for (int kk = 0; kk < 4; ++kk) {
    bf16x8 hfv[4], df[4];
#pragma unroll
    for (int n = 0; n < 4; ++n) hfv[n] = *(const bf16x8*)(Ht + (n * 16 + fr) * 136 + kk * 32 + fq * 8);
#pragma unroll
    for (int m = 0; m < 4; ++m) df[m] = *(const bf16x8*)(D + (size_t)(64 * w + 16 * m + fr) * 128 + kk * 32 + fq * 8);
#pragma unroll
    for (int n = 0; n < 4; ++n)
#pragma unroll
      for (int m = 0; m < 4; ++m) acc[n][m] = mfma16(hfv[n], df[m], acc[n][m]);
  }
  float* T = (float*)(p.ws + OFF_T);
#pragma unroll
  for (int m = 0; m < 4; ++m) {
    const int dr = 64 * w + 16 * m + fr, ri = dr >> 7, k1 = dr & 127;
    float* dst = T + ((size_t)(((b * 4 + g) * 128 + k1) * 2 + ri) * 64 + col) * 64;
#pragma unroll
    for (int n = 0; n < 4; ++n) *(f32x4*)(dst + n * 16 + fq * 4) = acc[n][m];
  }
}

DI void fft2_unit(const P& p, int layer, int u, char* smem) {
  const int tid = get_tid(), lane = tid & 63, w = tid >> 6, fr = lane & 15, fq = lane >> 4;
  const int b = u >> 9, k1 = (u >> 2) & 127, g = u & 3;
  u16* Xt = (u16*)smem;
  u16* Gt = Xt + 64 * 136;
  __syncthreads();
  const float* T = (const float*)(p.ws + OFF_T) + (size_t)(((b * 4 + g) * 128 + k1) * 2) * 4096;
  const float2* TW = (const float2*)(p.ws + OFF_TW) + k1 * 64;
#pragma unroll
  for (int i = 0; i < 4; ++i) {
    const int col = (tid >> 4) + 16 * i, c4 = (tid & 15) * 4;
    const float4 re = *(const float4*)(T + col * 64 + c4), im = *(const float4*)(T + 4096 + col * 64 + c4);
    const float2 tw = TW[col];
    const float rr[4] = {re.x, re.y, re.z, re.w}, ii[4] = {im.x, im.y, im.z, im.w};
#pragma unroll
    for (int e = 0; e < 4; ++e) {
      Xt[(c4 + e) * 136 + col] = bf1(rr[e] * tw.x - ii[e] * tw.y);
      Xt[(c4 + e) * 136 + 64 + col] = bf1(rr[e] * tw.y + ii[e] * tw.x);
    }
  }
  __syncthreads();
  {
    f32x4 acc[4][2];
#pragma unroll
    for (int n = 0; n < 4; ++n) { acc[n][0] = (f32x4){0.f, 0.f, 0.f, 0.f}; acc[n][1] = (f32x4){0.f, 0.f, 0.f, 0.f}; }
    const u16* D = (const u16*)(p.ws + OFF_D64);
#pragma unroll
    for (int kk = 0; kk < 4; ++kk) {
      bf16x8 xf[4], df[2];
#pragma unroll
      for (int n = 0; n < 4; ++n) xf[n] = *(const bf16x8*)(Xt + (n * 16 + fr) * 136 + kk * 32 + fq * 8);
#pragma unroll
      for (int m = 0; m < 2; ++m) df[m] = *(const bf16x8*)(D + (size_t)(32 * w + 16 * m + fr) * 128 + kk * 32 + fq * 8);
#pragma unroll
      for (int n = 0; n < 4; ++n)
#pragma unroll
        for (int m = 0; m < 2; ++m) acc[n][m] = mfma16(xf[n], df[m], acc[n][m]);
    }
#pragma unroll
    for (int m = 0; m < 2; ++m) {
      const int row2 = 32 * w + 16 * m + fr, ri = row2 >> 6, k2 = row2 & 63;
#pragma unroll
      for (int n = 0; n < 4; ++n) {
        uint2 o; o.x = pk2(acc[n][m][0], acc[n][m][1]); o.y = pk2(acc[n][m][2], acc[n][m][3]);
        *(uint2*)(Gt + k2 * 136 + ri * 64 + n * 16 + fq * 4) = o;
      }
    }
  }
  __syncthreads();
  {
    f32x4 acc[4];
#pragma unroll
    for (int n = 0; n < 4; ++n) acc[n] = (f32x4){0.f, 0.f, 0.f, 0.f};
    const u16* W = (const u16*)(p.ws + OFF_WCS) + (size_t)(layer * 4 + g) * 64 * 128;
#pragma unroll
    for (int kk = 0; kk < 4; ++kk) {
      const bf16x8 gf = *(const bf16x8*)(Gt + (16 * w + fr) * 136 + kk * 32 + fq * 8);
#pragma unroll
      for (int n = 0; n < 4; ++n) {
        const bf16x8 wf = *(const bf16x8*)(W + (size_t)(n * 16 + fr) * 128 + kk * 32 + fq * 8);
        acc[n] = mfma16(wf, gf, acc[n]);
      }
    }
    const int k2 = 16 * w + fr;
    u16* mix = (u16*)(p.ws + OFF_MIX) + (size_t)(b * 8192 + k1 + 128 * k2) * 1024 + 768 + g * 64;
#pragma unroll
    for (int n = 0; n < 4; ++n) {
      uint2 o; o.x = pk2(acc[n][0], acc[n][1]); o.y = pk2(acc[n][2], acc[n][3]);
      *(uint2*)(mix + n * 16 + fq * 4) = o;
    }
  }
}

DI void ctxfft_unit(const P& p, int layer, int u, char* smem) {
  const int tid = get_tid();
  const int b = u >> 6, g = (u >> 4) & 3, kb = u & 15;
  float2* tab = (float2*)smem;
  float* Gs = (float*)(smem + 2048);
  float* zs = Gs + 16 * 128;
  __syncthreads();
  { const float ang = 6.283185307179586f * (float)tid / 256.f; tab[tid] = make_float2(cosf(ang), sinf(ang)); }
  __syncthreads();
  const int kl = tid >> 4, c4 = (tid & 15) * 4, k = kb * 16 + kl;
  const float* F = (const float*)(p.ws + OFF_F) + (size_t)(XTOK + b * 256) * 256 + g * 64 + c4;
  float gr[4] = {0.f, 0.f, 0.f, 0.f}, gim[4] = {0.f, 0.f, 0.f, 0.f};
#pragma unroll 16
  for (int l = 0; l < 256; ++l) {
    const float4 hv = *(const float4*)(F + (size_t)l * 256);
    const float2 cs = tab[(k * l) & 255];
    gr[0] += cs.x * hv.x; gr[1] += cs.x * hv.y; gr[2] += cs.x * hv.z; gr[3] += cs.x * hv.w;
    gim[0] -= cs.y * hv.x; gim[1] -= cs.y * hv.y; gim[2] -= cs.y * hv.z; gim[3] -= cs.y * hv.w;
  }
#pragma unroll
  for (int e = 0; e < 4; ++e) { Gs[kl * 128 + c4 + e] = gr[e]; Gs[kl * 128 + 64 + c4 + e] = gim[e]; }
  __syncthreads();
  float z[4] = {0.f, 0.f, 0.f, 0.f};
  for (int c = 0; c < 64; ++c) {
    const float a = Gs[kl * 128 + c], bi = Gs[kl * 128 + 64 + c];
#pragma unroll
    for (int e = 0; e < 4; ++e) { const float2 cs = tab[((c * (c4 + e)) & 63) * 4]; z[e] += a * cs.x + bi * cs.y; }
  }
#pragma unroll
  for (int e = 0; e < 4; ++e) zs[kl * 64 + c4 + e] = z[e] * (1.f / 128.f);
  __syncthreads();
  const float* wf = p.w_fnet + (size_t)(layer * 4 + g) * 4096;
  float o[4] = {0.f, 0.f, 0.f, 0.f};
  for (int cp = 0; cp < 64; ++cp) {
    const float zv = zs[kl * 64 + cp];
    const float4 wv = *(const float4*)(wf + cp * 64 + c4);
    o[0] += zv * wv.x; o[1] += zv * wv.y; o[2] += zv * wv.z; o[3] += zv * wv.w;
  }
  u16* mix = (u16*)(p.ws + OFF_MIX) + (size_t)(XTOK + b * 256 + k) * 1024 + 768 + g * 64 + c4;
  uint2 ov; ov.x = pk2(o[0], o[1]); ov.y = pk2(o[2], o[3]);
  *(uint2*)mix = ov;
}


#define XB_TMO      128
#define XB_XCNT(j)  (256  + 64 * (j))
#define XB_XSUB(j)  (1280 + 64 * (j))
#define XB_XGEN(j)  (2304 + 64 * (j))
#define XB_TOP      3328
#define XB_TOPGEN   3392
#define XB_SPIN_CAP (1u << 18)
#define LAS __attribute__((address_space(3)))
DI unsigned xb_ld(unsigned* q) { return __hip_atomic_load(q, __ATOMIC_RELAXED, __HIP_MEMORY_SCOPE_AGENT); }
DI unsigned xb_add(unsigned* q, unsigned v) { return __hip_atomic_fetch_add(q, v, __ATOMIC_RELAXED, __HIP_MEMORY_SCOPE_AGENT); }
DI unsigned xb_xcc_id() { return (unsigned)__builtin_amdgcn_s_getreg((3 << 11) | 20) & 0xFu; }
#define XB_SPIN(cond, bar) do { unsigned _sp = 0; while (cond) { __builtin_amdgcn_s_sleep(1); \
    if ((++_sp & 255u) == 0u) { if (xb_ld(&(bar)[XB_TMO])) break; if (_sp > XB_SPIN_CAP) { atomicAdd(&(bar)[XB_TMO], 1u); break; } } } } while (0)
struct XcdBarrier { unsigned* bar; unsigned x; volatile LAS unsigned* st; };
DI XcdBarrier xcd_barrier_post(unsigned* bar, volatile LAS unsigned* st) {
  XcdBarrier b; b.bar = bar; b.x = xb_xcc_id(); b.st = st;
  if (threadIdx.x == 0) (void)xb_add(&bar[XB_XCNT(b.x)], 1u);
  return b;
}
DI void xcd_barrier_complete(unsigned* bar, unsigned x, unsigned& nloc, unsigned& nx) {
  const unsigned G = gridDim.x * gridDim.y * gridDim.z;
  unsigned sum, cnt, mine, sp = 0u;
  for (;;) {
    sum = 0u; cnt = 0u; mine = 0u;
#pragma unroll
    for (unsigned j = 0; j < 16; ++j) { const unsigned c = xb_ld(&bar[XB_XCNT(j)]); sum += c; cnt += (c > 0u) ? 1u : 0u; mine = (j == x) ? c : mine; }
    if (sum == G) break;
    __builtin_amdgcn_s_sleep(1);
    if ((++sp & 255u) == 0u) { if (xb_ld(&bar[XB_TMO])) break; if (sp > XB_SPIN_CAP) { atomicAdd(&bar[XB_TMO], 1u); break; } }
  }
  nloc = mine > 0u ? mine : 1u; nx = cnt > 0u ? cnt : 1u;
}
DI void xcd_barrier(const XcdBarrier& b) {
  asm volatile("s_waitcnt vmcnt(0)" ::: "memory");
  __syncthreads();
  if (threadIdx.x == 0) {
    unsigned* bar = b.bar;
    __builtin_amdgcn_s_waitcnt(0);
    unsigned nloc = b.st[0], nx = b.st[1];
    if (nloc == 0u) { xcd_barrier_complete(bar, b.x, nloc, nx); b.st[0] = nloc; b.st[1] = nx; }
    const unsigned old = xb_add(&bar[XB_XSUB(b.x)], 1u);
    const unsigned gen = old / nloc;
    if (old + 1u == (gen + 1u) * nloc) {
      __builtin_amdgcn_fence(__ATOMIC_RELEASE, "agent");
      asm volatile("s_waitcnt vmcnt(0)" ::: "memory");
      const unsigned og = xb_add(&bar[XB_TOP], 1u);
      const unsigned tg = og / nx;
      if (og + 1u == (tg + 1u) * nx) xb_add(&bar[XB_TOPGEN], 1u);
      else XB_SPIN(xb_ld(&bar[XB_TOPGEN]) == tg, bar);
      __builtin_amdgcn_fence(__ATOMIC_ACQUIRE, "agent");
      xb_add(&bar[XB_XGEN(b.x)], 1u);
      asm volatile("s_waitcnt vmcnt(0)" ::: "memory");
    } else {
      XB_SPIN(xb_ld(&bar[XB_XGEN(b.x)]) == gen, bar);
      __builtin_amdgcn_fence(__ATOMIC_ACQUIRE, "agent");
      asm volatile("s_waitcnt vmcnt(0)" ::: "memory");
    }
  }
  __syncthreads();
}

constexpr int NSUB = 10;
constexpr int NPHASE = 1 + DEPTH * NSUB;
DI int sub_of(int i) { return (int)((0x76d54983ba210cULL >> (4 * i)) & 15ULL); }

#define LOOPB(N, ROT, ...) do { const int n_ = (N); int br_ = B - (ROT); if (br_ < 0) br_ += G; \
    for (int u0_ = br_ & ~1; u0_ < n_; u0_ += G) { int u = u0_ + (br_ & 1); const bool dup = u >= n_; if (dup) u = n_ - 1; __VA_ARGS__; } } while (0)
#define LOOPG(N, CALL) do { const int n_ = (N); const int full_ = (n_ / G) * G; const int rem_ = n_ - full_; \
    for (int u = B; u < full_; u += G) { CALL(u, false, 0); } \
    if (rem_ > 0) { \
      if (rem_ * 2 <= G) { const int wg_ = B >> 1; if (wg_ < rem_) { CALL(full_ + wg_, false, (B & 1) + 1); } } \
      else { const int u0_ = full_ + (B & ~1); if (u0_ < n_) { int u = u0_ + (B & 1); const bool dup = u >= n_; if (dup) u = n_ - 1; CALL(u, dup, -1); } } \
    } } while (0)
#define LOOPN(N, ROT, ...) do { const int n_ = (N); int br_ = B - (ROT); if (br_ < 0) br_ += G; \
    for (int u = br_; u < n_; u += G) { __VA_ARGS__; } } while (0)

DI void run_phase(const P& p, int ph, char* smem) {
  const int G = gridDim.x * 2, B = blockIdx.x * 2 + __builtin_amdgcn_readfirstlane(threadIdx.x >> 8);
  char* ws = p.ws;
  char* smem_o = (B & 1) ? smem - LDS_BYTES : smem + LDS_BYTES;
  if (ph == 0) {
    LOOPB(11328, 0, prep_transposes(p, u, smem));
    LOOPB(384, 0, prep_mod(p, u, smem));
    LOOPN(32, 384, prep_disc(p, u));
    LOOPN(N_TABLE_UNITS, 0, prep_tables(p, u));
    LOOPN(512, 0, prep_wcs(p, u));
    LOOPN(1024, 0, prep_cm(p, u));
    return;
  }
  const int layer = (ph - 1) / NSUB, sub = (ph - 1) % NSUB;
  const bool lastl = layer == DEPTH - 1;
  const int nmt = lastl ? 128 : 132;
  switch (sub) {
    case 0: LOOPN(2112, 0, norm_unit(p, layer, 0, u)); break;
    case 1: {
      const u16* Wt = (const u16*)(ws + OFF_WIN) + (size_t)layer * 2048 * 1024;
#define CALL_(u, dup, role) gemm_unit<1, EPI_PROJ>(p, layer, (u) >> 4, (u) & 15, 1024, Wt, ws + OFF_HN, 1024, nullptr, nullptr, nullptr, smem, dup, role, smem_o)
      LOOPG(132 * 16, CALL_);
#undef CALL_
    } break;
    case 2: {
      LOOPB(512, 0, (ssm_unit<false, false>(p, layer, u >> 8, u & 255, smem)));
      LOOPB(16, 0, (ssm_unit<false, false>(p, layer, u >> 3, 256 + (u & 7), smem)));
      LOOPB(512, 0, fft1_unit(p, u, smem));
      if (!lastl) LOOPB(128, 16, ctxfft_unit(p, layer, u, smem));
    } break;
    case 3: {
      LOOPB(128, 0, ssm_carry_unit(p, layer, u, smem));
      if (!lastl) LOOPB(16, 128, (ssm_unit<true, true>(p, layer, u >> 3, 256 + (u & 7), smem)));
      if (!lastl) LOOPB(16, 144, attn_unit(p, layer, 512 + u, smem, smem_o));
      LOOPB(1024, 0, fft2_unit(p, layer, u, smem));
    } break;
    case 4: {
      LOOPB(512, 0, attn_unit(p, layer, (G == 512 ? ((((u >> 1) & 7) << 6) | ((u >> 4) << 1) | (u & 1)) : u), smem, smem_o));
      LOOPB(512, 0, (ssm_unit<true, false>(p, layer, u >> 8, u & 255, smem)));
    } break;
    case 5: {
      const u16* Wt = (const u16*)(ws + OFF_WGLU) + (size_t)layer * 256 * 256;
      LOOPB(nmt * 2, 0, (gemm_unit<1, EPI_GLU>(p, layer, u >> 1, u & 1, 256, Wt, ws + OFF_HGLU, 256, nullptr, nullptr, nullptr, smem, dup)));
    } break;
    case 6: {
      const u16* Wt = (const u16*)(ws + OFF_WOUT) + (size_t)layer * 1024 * 1024;
#define CALL_(u, dup, role) gemm_unit<1, EPI_OUT>(p, layer, (u) >> 3, (u) & 7, 1024, Wt, ws + OFF_MIX, 1024, nullptr, nullptr, nullptr, smem, dup, role, smem_o)
      LOOPG(nmt * 8, CALL_);
#undef CALL_
    } break;
    case 7: LOOPN(nmt * 16, 0, norm_unit(p, layer, 1, u)); break;
    case 8: {
      const u16* Wt = (const u16*)(ws + OFF_WFF1) + (size_t)layer * 4096 * 1024;
#define CALL_(u, dup, role) gemm_unit<1, EPI_FF1>(p, layer, (u) >> 5, (u) & 31, 1024, Wt, ws + OFF_HN, 1024, nullptr, nullptr, nullptr, smem, dup, role, smem_o)
      LOOPG(nmt * 32, CALL_);
#undef CALL_
    } break;
    case 9: {
      const u16* Wt = (const u16*)(ws + OFF_WFF2) + (size_t)layer * 1024 * 4096;
#define CALL_(u, dup, role) gemm_unit<1, EPI_FF2>(p, layer, (u) >> 3, (u) & 7, 4096, Wt, ws + OFF_HID, 4096, nullptr, nullptr, nullptr, smem, dup, role, smem_o)
      LOOPG(nmt * 8, CALL_);
#undef CALL_
    } break;
  }
}

__global__ void __launch_bounds__(512) mega(P p, int ph_lo, int ph_hi, int coop) {
  __shared__ __attribute__((aligned(16))) char smem_all[2 * LDS_BYTES];
  __shared__ uint4 xb_words;
  char* smem = smem_all + __builtin_amdgcn_readfirstlane(threadIdx.x >> 8) * LDS_BYTES;
  if (threadIdx.x == 0) xb_words = make_uint4(0u, 0u, 0u, 0u);
  __syncthreads();
  XcdBarrier xb = xcd_barrier_post((unsigned*)(p.ws + OFF_BAR), (volatile LAS unsigned*)&xb_words);
  for (int ph = ph_lo; ph < ph_hi; ++ph) {
    P q = p;
    asm volatile("" : "+s"(q.ws));
    run_phase(q, ph, smem);
    if (coop && ph + 1 < ph_hi) {
      if (ph == ph_lo) {
        asm volatile("s_waitcnt vmcnt(0)" ::: "memory");
        cg::this_grid().sync();
        if (threadIdx.x < 64) {
          __builtin_amdgcn_fence(__ATOMIC_ACQUIRE, "agent");
          asm volatile("s_waitcnt vmcnt(0)" ::: "memory");
        }
        __syncthreads();
      } else {
        xcd_barrier(xb);
      }
    }
  }
}

#ifdef DBG_DUMP
__global__ void __launch_bounds__(256) dumpk(P p) {
  const size_t n = (size_t)XTOK * 1024;
  for (size_t i = (size_t)blockIdx.x * 256 + threadIdx.x; i < n; i += (size_t)gridDim.x * 256) {
#if DBG_DUMP == 0
    { const int cc = (int)(i & 1023); p.out[i] = (cc >= DBG_CLO && cc < DBG_CHI) ? bf2f(((const u16*)(p.ws + OFF_MIX))[i]) : 0.f; }
#elif DBG_DUMP == 8
    p.out[i] = i < (size_t)512 * 1024 ? bf2f(((const u16*)(p.ws + OFF_MIX))[(size_t)XTOK * 1024 + i]) : 0.f;
#elif DBG_DUMP == 9
    p.out[i] = i < (size_t)512 * 1024 ? ((const float*)(p.ws + OFF_XBUF))[(size_t)XTOK * 1024 + i] : 0.f;
#elif DBG_DUMP == 10
    p.out[i] = ((const float*)(p.ws + OFF_T))[i % ((size_t)8388608)];
#elif DBG_DUMP == 11
    p.out[i] = bf2f(((const u16*)(p.ws + OFF_WIN))[(size_t)3 * 2048 * 1024 + (i % ((size_t)2048 * 1024))]);
#elif DBG_DUMP == 13
    p.out[i] = bf2f(((const u16*)(p.ws + OFF_WIN))[(size_t)3 * 2048 * 1024 + (i % ((size_t)2048 * 1024))]) + ((const float*)(p.ws + OFF_MOD))[i % ((size_t)4 * 3 * 6144)];
#elif DBG_DUMP == 12
    p.out[i] = ((const float*)(p.ws + OFF_MOD))[i % ((size_t)4 * 3 * 6144)];
#elif DBG_DUMP == 1
    p.out[i] = ((const float*)(p.ws + OFF_XBUF))[i];
#elif DBG_DUMP == 2
    p.out[i] = bf2f(((const u16*)(p.ws + OFF_Q))[i % ((size_t)2*4*2*8192*64)]) + bf2f(((const u16*)(p.ws + OFF_K))[i % ((size_t)2*4*2*8448*64)]) + bf2f(((const u16*)(p.ws + OFF_VT))[i % ((size_t)2*4*8448*128)]);
#elif DBG_DUMP == 3
    p.out[i] = ((const float*)(p.ws + OFF_U))[i % ((size_t)NTOK*256)] + ((const float*)(p.ws + OFF_F))[i % ((size_t)NTOK*256)];
#elif DBG_DUMP == 4
    p.out[i] = bf2f(((const u16*)(p.ws + OFF_HGLU))[i % ((size_t)NTOK*256)]);
#endif
  }
}
#endif

extern "C" void kernel_launch(void* const* d_in, const int* in_sizes, int n_in, void* d_out, int out_size, void* d_ws, size_t ws_size,
                              hipStream_t stream) {
  static int grid_blocks = 0;
  if (!grid_blocks) {
    int dev = 0, cus = 0, per_cu = 0;
    hipGetDevice(&dev);
    hipDeviceGetAttribute(&cus, hipDeviceAttributeMultiprocessorCount, dev);
    hipOccupancyMaxActiveBlocksPerMultiprocessor(&per_cu, mega, 512, 0);
    if (per_cu < 1) per_cu = 1;
    if (per_cu > 1) per_cu = 1;
    grid_blocks = cus * per_cu;
  }
  if (ws_size < WS_NEED) { fprintf(stderr, "workspace too small: %zu < %zu\n", ws_size, (size_t)WS_NEED); return; }
  P p{};
  const float** pp = (const float**)&p;
  for (int i = 0; i < 30; ++i) pp[i] = (const float*)d_in[i];
  p.out = (float*)d_out;
  p.ws = (char*)d_ws;
#ifdef DBG_MEMSET
  hipMemsetAsync(d_ws, 0, WS_NEED, stream);
#endif
  hipMemsetAsync((char*)d_ws + OFF_BAR, 0, BAR_BYTES, stream);
#if COOP
#ifdef DBG_STOP
  int lo = 0, hi = DBG_STOP, coop = 1;
#else
  int lo = 0, hi = NPHASE, coop = 1;
#endif
  void* args[] = {&p, &lo, &hi, &coop};
  hipError_t e = hipLaunchCooperativeKernel((void*)mega, dim3(grid_blocks), dim3(512), args, 0, stream);
  if (e != hipSuccess) fprintf(stderr, "cooperative launch failed: %s (grid %d)\n", hipGetErrorString(e), grid_blocks);
#ifdef DBG_DUMP
  dumpk<<<dim3(1024), dim3(256), 0, stream>>>(p);
#endif
#else
#ifdef DBG_STOP
  for (int ph = 0; ph < DBG_STOP; ++ph) mega<<<dim3(grid_blocks), dim3(512), 0, stream>>>(p, ph, ph + 1, 0);
#else
  for (int ph = 0; ph < NPHASE; ++ph) mega<<<dim3(grid_blocks), dim3(512), 0, stream>>>(p, ph, ph + 1, 0);
#endif
#ifdef DBG_DUMP
  dumpk<<<dim3(1024), dim3(256), 0, stream>>>(p);
#endif
#endif
}
```

```cpp
#include <hip/hip_runtime.h>
#include <hip/hip_cooperative_groups.h>
#include <cstdio>
#include <cstdint>
namespace cg = cooperative_groups;

#ifndef COOP
#define COOP 1
#endif

#define DI __device__ __forceinline__
typedef unsigned short u16;
typedef short bf16x8 __attribute__((ext_vector_type(8)));
typedef float f32x4 __attribute__((ext_vector_type(4)));
typedef float f32x16 __attribute__((ext_vector_type(16)));
typedef __bf16 bf16v2 __attribute__((ext_vector_type(2)));
typedef float f32v2 __attribute__((ext_vector_type(2)));

constexpr int DM = 1024, NBATCH = 2, SEQ = 8192, DEPTH = 4, CTX = 256;
constexpr int XTOK = NBATCH * SEQ;
constexpr int NTOK = XTOK + NBATCH * CTX;
constexpr int LK = CTX + SEQ;
constexpr int NKT = LK / 32;
constexpr int NCH = LK / 32;
constexpr int DFF = 4096;
constexpr int LDS_BYTES = 77824;
constexpr float EPS = 1e-6f;
constexpr float LOG2E = 1.4426950408889634f;

constexpr size_t AL(size_t x) { return (x + 255) & ~(size_t)255; }
constexpr size_t OFF_WIN = 0;
constexpr size_t OFF_WOUT = OFF_WIN + AL((size_t)DEPTH * 2048 * 1024 * 2);
constexpr size_t OFF_WFF1 = OFF_WOUT + AL((size_t)DEPTH * 1024 * 1024 * 2);
constexpr size_t OFF_WFF2 = OFF_WFF1 + AL((size_t)DEPTH * 4096 * 1024 * 2);
constexpr size_t OFF_WGLU = OFF_WFF2 + AL((size_t)DEPTH * 4096 * 1024 * 2);
constexpr size_t OFF_XBUF = OFF_WGLU + AL((size_t)DEPTH * 256 * 256 * 2);
constexpr size_t OFF_MIX = OFF_XBUF + AL((size_t)NTOK * 1024 * 4);
constexpr size_t OFF_MOD = OFF_MIX + AL((size_t)NTOK * 1024 * 2);
constexpr size_t OFF_SMALL = OFF_MOD + AL((size_t)DEPTH * 3 * 6144 * 4);
constexpr size_t OFF_AB = OFF_SMALL + 256;
constexpr size_t OFF_AT = OFF_AB + AL((size_t)DEPTH * 2 * 16 * 64 * 2 * 4);
constexpr size_t OFF_BBAR = OFF_AT + AL((size_t)DEPTH * 2 * 16 * 64 * 2 * 4);
constexpr size_t OFF_CM = OFF_BBAR + AL((size_t)DEPTH * 2 * 16 * 64 * 32 * 4);
constexpr size_t OFF_ROPE = OFF_CM + AL((size_t)DEPTH * 2 * 16 * 16 * 128 * 2);
constexpr size_t OFF_D128 = OFF_ROPE + AL((size_t)192 * 16 * 8);
constexpr size_t OFF_D64 = OFF_D128 + AL((size_t)256 * 128 * 2);
constexpr size_t OFF_TW = OFF_D64 + AL((size_t)128 * 128 * 2);
constexpr size_t OFF_WCS = OFF_TW + AL((size_t)128 * 64 * 8);
constexpr size_t OFF_R1 = OFF_WCS + AL((size_t)DEPTH * 4 * 64 * 128 * 2);
constexpr size_t OFF_HID = OFF_R1;
constexpr size_t OFF_Q = OFF_R1;
constexpr size_t OFF_QC = OFF_Q + AL((size_t)2 * 4 * 2 * 8192 * 64 * 2);
constexpr size_t OFF_K = OFF_QC + AL((size_t)2 * 4 * 2 * 256 * 64 * 2);
constexpr size_t OFF_VT = OFF_K + AL((size_t)2 * 4 * 2 * LK * 64 * 2);
constexpr size_t OFF_U = OFF_VT + AL((size_t)2 * 4 * LK * 128 * 2);
constexpr size_t OFF_F = OFF_U + AL((size_t)NTOK * 256 * 4);
constexpr size_t OFF_LOCAL = OFF_F + AL((size_t)NTOK * 256 * 4);
constexpr size_t OFF_CARRY = OFF_LOCAL + AL((size_t)2 * 2 * NCH * 1024 * 8);
constexpr size_t OFF_T = OFF_CARRY + AL((size_t)2 * 2 * NCH * 1024 * 8);
constexpr size_t OFF_HGLU = OFF_T + AL((size_t)2 * 4 * 128 * 2 * 64 * 64 * 4);
constexpr size_t OFF_END_MIX = OFF_HGLU + AL((size_t)NTOK * 256 * 2);
constexpr size_t OFF_END_HID = OFF_HID + AL((size_t)NTOK * 4096 * 2);
constexpr size_t OFF_XCTX2 = OFF_END_MIX > OFF_END_HID ? OFF_END_MIX : OFF_END_HID;
constexpr size_t OFF_HN = OFF_XCTX2 + AL((size_t)NBATCH * CTX * 1024 * 4);
constexpr size_t OFF_BAR = OFF_HN + AL((size_t)NTOK * 1024 * 2);
constexpr size_t BAR_BYTES = 3456 * 4;
constexpr size_t OFF_BBH = OFF_BAR + AL(BAR_BYTES);
constexpr size_t WS_NEED = OFF_BBH + AL((size_t)DEPTH * 2 * 16 * 128 * 16 * 2);

struct P {
  const float *x, *c, *ctx, *c_ctx, *w_mod, *b_mod, *g_norm1, *w_in, *g_qnorm, *g_knorm, *lam_q1, *lam_k1, *lam_q2, *lam_k2,
      *g_subln, *ssm_a_re, *ssm_a_im, *ssm_log_dt, *ssm_b_re, *ssm_b_im, *ssm_c_re, *ssm_c_im, *ssm_d, *w_glu, *b_glu, *w_fnet,
      *w_out, *g_norm2, *w_ff1, *w_ff2;
  float* out;
  char* ws;
};

DI unsigned pk2(float a, float b) { f32v2 v = {a, b}; return __builtin_bit_cast(unsigned, __builtin_convertvector(v, bf16v2)); }
DI u16 bf1(float a) { return (u16)(pk2(a, 0.f) & 0xffffu); }
DI float bf2f(u16 h) { return __uint_as_float(((unsigned)h) << 16); }
DI f32x4 mfma16(bf16x8 a, bf16x8 b, f32x4 c) { return __builtin_amdgcn_mfma_f32_16x16x32_bf16(a, b, c, 0, 0, 0); }
DI f32x16 mfma32(bf16x8 a, bf16x8 b, f32x16 c) { return __builtin_amdgcn_mfma_f32_32x32x16_bf16(a, b, c, 0, 0, 0); }
DI float silu(float v) { return v / (1.f + __expf(-v)); }
DI float gelu_tanh(float v) { float t = 0.7978845608028654f * (v + 0.044715f * v * v * v); return 0.5f * v * (1.f + tanhf(t)); }
DI int get_tid() { int t = threadIdx.x & 255; asm volatile("" : "+v"(t)); return t; }
DI void opaque_zero2(float& a, float& b) { asm volatile("v_mov_b32 %0, 0\n\tv_mov_b32 %1, 0" : "=v"(a), "=v"(b)); }
DI float* xa_tile(const P& p, int mt) { return (float*)(p.ws + OFF_XBUF) + (size_t)mt * 128 * 1024; }
DI const float* xa_rd_tile(const P& p, int layer, int mt) {
  if (layer == 0) return mt < 128 ? p.x + (size_t)mt * 128 * 1024 : p.ctx + (size_t)(mt - 128) * 128 * 1024;
  return (const float*)(p.ws + OFF_XBUF) + (size_t)mt * 128 * 1024;
}
DI float* xb_tile(const P& p, int mt) { return mt < 128 ? p.out + (size_t)mt * 128 * 1024 : (float*)(p.ws + OFF_XCTX2) + (size_t)(mt - 128) * 128 * 1024; }
DI float lam_init_of(int layer) { return 0.8f - 0.6f * expf(-0.3f * (float)layer); }

DI void tr_unit(const float* __restrict__ src, u16* __restrict__ dst, int K, int N, int u, char* smem) {
  float* t = (float*)smem;
  const int tid = get_tid();
  const int tnN = N / 64, tk = u / tnN, tn = u % tnN;
  __syncthreads();
#pragma unroll
  for (int i = 0; i < 4; ++i) {
    const int k = (tid >> 4) + 16 * i, n4 = (tid & 15) * 4;
    *(float4*)(t + k * 68 + n4) = *(const float4*)(src + (size_t)(tk * 64 + k) * N + tn * 64 + n4);
  }
  __syncthreads();
#pragma unroll
  for (int i = 0; i < 2; ++i) {
    const int item = tid + 256 * i, n = item >> 3, kb = (item & 7) * 8;
    const float* tp = t + kb * 68 + n;
    uint4 o;
    o.x = pk2(tp[0], tp[68]); o.y = pk2(tp[2 * 68], tp[3 * 68]); o.z = pk2(tp[4 * 68], tp[5 * 68]); o.w = pk2(tp[6 * 68], tp[7 * 68]);
    *(uint4*)(dst + (size_t)(tn * 64 + n) * K + tk * 64 + kb) = o;
  }
}

DI void prep_transposes(const P& p, int u, char* smem) {
  const int l = u / 2832; int r = u % 2832;
  char* ws = p.ws;
  if (r < 512) { tr_unit(p.w_in + (size_t)l * 1024 * 2048, (u16*)(ws + OFF_WIN) + (size_t)l * 2048 * 1024, 1024, 2048, r, smem); return; }
  r -= 512;
  if (r < 256) { tr_unit(p.w_out + (size_t)l * 1024 * 1024, (u16*)(ws + OFF_WOUT) + (size_t)l * 1024 * 1024, 1024, 1024, r, smem); return; }
  r -= 256;
  if (r < 1024) { tr_unit(p.w_ff1 + (size_t)l * 1024 * 4096, (u16*)(ws + OFF_WFF1) + (size_t)l * 4096 * 1024, 1024, 4096, r, smem); return; }
  r -= 1024;
  if (r < 1024) { tr_unit(p.w_ff2 + (size_t)l * 4096 * 1024, (u16*)(ws + OFF_WFF2) + (size_t)l * 1024 * 4096, 4096, 1024, r, smem); return; }
  r -= 1024;
  tr_unit(p.w_glu + (size_t)l * 256 * 256, (u16*)(ws + OFF_WGLU) + (size_t)l * 256 * 256, 256, 256, r, smem);
}

DI void prep_copy(const P& p, int u) {
  float4* dst = (float4*)(p.ws + OFF_XBUF);
  const float4* sx = (const float4*)p.x; const float4* sc = (const float4*)p.ctx;
  const size_t nx4 = (size_t)XTOK * 256;
const int tid = get_tid();
#pragma unroll 4
  for (int i = 0; i < 16; ++i) {
    const size_t idx = (size_t)u * 4096 + i * 256 + tid;
    dst[idx] = idx < nx4 ? sx[idx] : sc[idx - nx4];
  }
}

DI void prep_mod(const P& p, int u, char* smem) {
  float* act = (float*)smem;
  float* red = act + 3072;
  const int tid = get_tid();
  const int l = u / 96, jb = u % 96;
  __syncthreads();
  for (int i = tid; i < 3072; i += 256) {
    const int r = i >> 10, k = i & 1023;
    const float v = r < 2 ? p.c[r * 1024 + k] : p.c_ctx[k];
    act[i] = silu(v);
  }
  __syncthreads();
  const int j = jb * 64 + (tid & 63), kg = tid >> 6;
  float a0 = 0.f, a1 = 0.f, a2 = 0.f;
  const float* wp = p.w_mod + (size_t)l * 1024 * 6144 + j;
#pragma unroll 32
  for (int k = kg * 256; k < kg * 256 + 256; ++k) {
    const float wv = wp[(size_t)k * 6144];
    a0 += act[k] * wv; a1 += act[1024 + k] * wv; a2 += act[2048 + k] * wv;
  }
  red[(kg * 3 + 0) * 64 + (tid & 63)] = a0; red[(kg * 3 + 1) * 64 + (tid & 63)] = a1; red[(kg * 3 + 2) * 64 + (tid & 63)] = a2;
  __syncthreads();
  if (tid < 192) {
    const int r = tid >> 6, jj = tid & 63;
    float s = p.b_mod[l * 6144 + jb * 64 + jj];
    for (int q = 0; q < 4; ++q) s += red[(q * 3 + r) * 64 + jj];
    ((float*)(p.ws + OFF_MOD))[((size_t)l * 3 + r) * 6144 + jb * 64 + jj] = s;
  }
}

DI void prep_disc(const P& p, int u) {
  const int idx = u * 256 + get_tid();
  const int g = (idx >> 6) & 15;
  const int ld = idx >> 10;
  const float are = p.ssm_a_re[idx], aim = p.ssm_a_im[idx];
  const float dt = expf(p.ssm_log_dt[ld * 16 + g]);
  const float mag = expf(dt * are);
  const float abr = mag * cosf(dt * aim), abi = mag * sinf(dt * aim);
  const float den = are * are + aim * aim, nre = abr - 1.f;
  const float fre = (nre * are + abi * aim) / den, fim = (abi * are - nre * aim) / den;
  float2* AB = (float2*)(p.ws + OFF_AB); float2* AT = (float2*)(p.ws + OFF_AT);
  AB[idx] = make_float2(abr, abi);
  float tr = abr, ti = abi;
#pragma unroll
  for (int i = 0; i < 5; ++i) { const float nr = tr * tr - ti * ti, ni = 2.f * tr * ti; tr = nr; ti = ni; }
  AT[idx] = make_float2(tr, ti);
  float* bb = (float*)(p.ws + OFF_BBAR) + (size_t)idx * 32;
  const float* bre = p.ssm_b_re + (size_t)idx * 16; const float* bim = p.ssm_b_im + (size_t)idx * 16;
  for (int q = 0; q < 16; ++q) {
    const float br = bre[q], bi = bim[q];
    bb[q] = fre * br - fim * bi; bb[16 + q] = fre * bi + fim * br;
    u16* bh = (u16*)(p.ws + OFF_BBH) + ((size_t)(ld * 16 + g) * 128 + 2 * (idx & 63)) * 16;
    bh[q] = bf1(fre * br - fim * bi); bh[16 + q] = bf1(fre * bi + fim * br);
  }
}

DI void prep_tables(const P& p, int u) {
  const int i = u * 256 + get_tid();
  const float TWO_PI = 6.283185307179586f;
  char* ws = p.ws;
  if (i < 3072) {
    const int pos = i >> 4, j = i & 15;
    const float inv = powf(10000.f, -(float)j / 16.f);
    const float ang = (float)(pos < 128 ? pos : pos - 128) * inv;
    ((float2*)(ws + OFF_ROPE))[i] = make_float2(cosf(ang), sinf(ang));
    return;
  }
  int r = i - 3072;
  if (r < 32768) {
    const int row = r >> 7, rr = r & 127, ri = row >> 7, k1 = row & 127;
    const float ang = TWO_PI * (float)((k1 * rr) & 127) / 128.f;
    ((u16*)(ws + OFF_D128))[r] = bf1(ri == 0 ? cosf(ang) : -sinf(ang));
    return;
  }
  r -= 32768;
  if (r < 16384) {
    const int row = r >> 7, kx = r & 127, ri = row >> 6, k2 = row & 63, xri = kx >> 6, col = kx & 63;
    const float ang = TWO_PI * (float)((k2 * col) & 63) / 64.f;
    const float cr = cosf(ang), sr = sinf(ang);
    const float v = ri == 0 ? (xri == 0 ? cr : sr) : (xri == 0 ? -sr : cr);
    ((u16*)(ws + OFF_D64))[r] = bf1(v);
    return;
  }
  r -= 16384;
  if (r < 8192) {
    const int k1 = r >> 6, col = r & 63;
    const float ang = TWO_PI * (float)(k1 * col) / 8192.f;
    ((float2*)(ws + OFF_TW))[r] = make_float2(cosf(ang), -sinf(ang));
    return;
  }
  r -= 8192;
  if (r < DEPTH) {
    const int l = r;
    float s1 = 0.f, s2 = 0.f, gq = 0.f, gk = 0.f;
    for (int q = 0; q < 64; ++q) {
      s1 += p.lam_q1[l * 64 + q] * p.lam_k1[l * 64 + q]; s2 += p.lam_q2[l * 64 + q] * p.lam_k2[l * 64 + q];
      gq = fmaxf(gq, fabsf(p.g_qnorm[l * 64 + q])); gk = fmaxf(gk, fabsf(p.g_knorm[l * 64 + q]));
    }
    float* sm = (float*)(ws + OFF_SMALL);
    sm[l] = expf(s1) - expf(s2) + lam_init_of(l);
    sm[4 + l] = 8.f * gq * gk * LOG2E;
  }
}
constexpr int N_TABLE_UNITS = (3072 + 32768 + 16384 + 8192 + DEPTH + 255) / 256;

DI void prep_wcs(const P& p, int u) {
  const int idx = u * 256 + get_tid();
  const int k = idx & 127, d = (idx >> 7) & 63, lg = idx >> 13;
  const int ri = k >> 6, c = k & 63;
  const float* wf = p.w_fnet + (size_t)lg * 4096;
  float s = 0.f;
  for (int cp = 0; cp < 64; ++cp) {
    const float ang = 6.283185307179586f * (float)((c * cp) & 63) / 64.f;
    s += (ri == 0 ? cosf(ang) : sinf(ang)) * wf[cp * 64 + d];
  }
  ((u16*)(p.ws + OFF_WCS))[idx] = bf1(s * (1.f / 724.0773439350247f));
}

DI void prep_cm(const P& p, int u) {
  const int idx = u * 256 + get_tid();
  const int k = idx & 127, row = idx >> 7;
  const float v = k < 64 ? p.ssm_c_re[(size_t)row * 64 + k] : -p.ssm_c_im[(size_t)row * 64 + (k - 64)];
  ((u16*)(p.ws + OFF_CM))[idx] = bf1(v);
}


DI void norm_unit(const P& p, int layer, int which, int u) {
  const int tid = get_tid(), lane = tid & 63;
  const int r = u * 8 + (tid >> 6);
  const int mt = r >> 7;
  const float* xrow = (which == 0 ? xa_rd_tile(p, layer, mt) : (const float*)xb_tile(p, mt)) + (size_t)(r & 127) * 1024 + lane * 4;
  const float* modl = (const float*)(p.ws + OFF_MOD) + ((size_t)layer * 3 + (r < XTOK ? (r >> 13) : 2)) * 6144 + lane * 4;
  const float* sh = modl + (which == 0 ? 0 : 3072);
  const float* sc = modl + (which == 0 ? 1024 : 4096);
  const float* gn = (which == 0 ? p.g_norm1 : p.g_norm2) + layer * 1024 + lane * 4;
  const float4 v0 = *(const float4*)(xrow), v1 = *(const float4*)(xrow + 256), v2 = *(const float4*)(xrow + 512), v3 = *(const float4*)(xrow + 768);
  const float4 w0 = *(const float4*)(xrow + 4096), w1 = *(const float4*)(xrow + 4096 + 256), w2 = *(const float4*)(xrow + 4096 + 512), w3 = *(const float4*)(xrow + 4096 + 768);
  float4 g0 = *(const float4*)(gn), g1 = *(const float4*)(gn + 256), g2 = *(const float4*)(gn + 512), g3 = *(const float4*)(gn + 768);
  const float4 s0 = *(const float4*)(sc), s1 = *(const float4*)(sc + 256), s2 = *(const float4*)(sc + 512), s3 = *(const float4*)(sc + 768);
  const float4 h0 = *(const float4*)(sh), h1 = *(const float4*)(sh + 256), h2 = *(const float4*)(sh + 512), h3 = *(const float4*)(sh + 768);
#define SSQ4(V) (V.x * V.x + V.y * V.y + V.z * V.z + V.w * V.w)
  float ssa = SSQ4(v0) + SSQ4(v1) + SSQ4(v2) + SSQ4(v3), ssb = SSQ4(w0) + SSQ4(w1) + SSQ4(w2) + SSQ4(w3);
#undef SSQ4
#pragma unroll
  for (int o = 1; o < 64; o <<= 1) { ssa += __shfl_xor(ssa, o); ssb += __shfl_xor(ssb, o); }
  const float ra = rsqrtf(ssa * (1.f / 1024.f) + EPS), rb = rsqrtf(ssb * (1.f / 1024.f) + EPS);
  g0.x *= 1.f + s0.x; g0.y *= 1.f + s0.y; g0.z *= 1.f + s0.z; g0.w *= 1.f + s0.w;
  g1.x *= 1.f + s1.x; g1.y *= 1.f + s1.y; g1.z *= 1.f + s1.z; g1.w *= 1.f + s1.w;
  g2.x *= 1.f + s2.x; g2.y *= 1.f + s2.y; g2.z *= 1.f + s2.z; g2.w *= 1.f + s2.w;
  g3.x *= 1.f + s3.x; g3.y *= 1.f + s3.y; g3.z *= 1.f + s3.z; g3.w *= 1.f + s3.w;
  u16* dst = (u16*)(p.ws + OFF_HN) + (size_t)r * 1024 + lane * 4;
#define NORM_ST(V, RS, Gv, Hv, OFS) do { uint2 o; \
    o.x = pk2(V.x * RS * Gv.x + Hv.x, V.y * RS * Gv.y + Hv.y); \
    o.y = pk2(V.z * RS * Gv.z + Hv.z, V.w * RS * Gv.w + Hv.w); \
    *(uint2*)(dst + (OFS)) = o; } while (0)
  NORM_ST(v0, ra, g0, h0, 0); NORM_ST(v1, ra, g1, h1, 256); NORM_ST(v2, ra, g2, h2, 512); NORM_ST(v3, ra, g3, h3, 768);
  NORM_ST(w0, rb, g0, h0, 4096); NORM_ST(w1, rb, g1, h1, 4096 + 256); NORM_ST(w2, rb, g2, h2, 4096 + 512); NORM_ST(w3, rb, g3, h3, 4096 + 768);
#undef NORM_ST
}

enum { EPI_PROJ = 0, EPI_OUT = 1, EPI_FF1 = 2, EPI_FF2 = 3, EPI_GLU = 4 };
constexpr int LDT = 72;

template <int AMODE, int EPI>
DI void gemm_unit(const P& p, int layer, int mt, int nt, int K, const u16* __restrict__ Wt, const void* __restrict__ Asrc, int lda,
                  const float* gn, const float* sc, const float* sh, char* smem, bool dup, int role = -1, char* smem_other = nullptr) {
  const int tid = get_tid(), lane = tid & 63, w = tid >> 6, wr = w >> 1, wc = w & 1, fr = lane & 15, fq = lane >> 4;
  u16* As = (u16*)smem;
  u16* Bs = As + 2 * 128 * LDT;
  float* rs = (float*)(Bs + 2 * 128 * LDT);
  const int rmod = mt < 128 ? (mt >> 6) : 2;
  const float* modl = (const float*)(p.ws + OFF_MOD) + ((size_t)layer * 3 + rmod) * 6144;
  __syncthreads();
  f32x4 acc[4][4];
#pragma unroll
  for (int m = 0; m < 4; ++m)
#pragma unroll
    for (int n = 0; n < 4; ++n) acc[m][n] = (f32x4){0.f, 0.f, 0.f, 0.f};

  uint4 p0, p1, p2, p3, q0, q1, q2, q3;
  uint4 r0, r1, r2, r3, t0, t1, t2, t3;
  uint4 x0, x1, x2, x3, z0, z1, z2, z3;
  const int nk = role > 0 ? K / 128 : K / 64;
  const int kofs = role == 2 ? K / 2 : 0;
  const bool share = role == 0;
  const bool hi = share && smem_other < smem;
  const u16* Ag = (const u16*)Asrc + (size_t)(mt * 128 + (share && hi ? 64 : 0) + (tid >> 3)) * lda + (tid & 7) * 8 + kofs;
  const u16* afb = share ? ((wr == (hi ? 1 : 0)) ? As : (const u16*)smem_other) : As + wr * 64 * LDT;
  const u16* Bg = Wt + (size_t)(nt * 128 + (tid >> 3)) * K + (tid & 7) * 8 + kofs;
  const int lrow = ((tid >> 3)) * LDT + (tid & 7) * 8;
#define GLOAD(A0, A1, A2, A3, B0, B1, B2, B3, kt)                                                 \
  do {                                                                                            \
    B0 = *(const uint4*)(Bg + (kt) * 64); B1 = *(const uint4*)(Bg + (size_t)32 * K + (kt) * 64);  \
    B2 = *(const uint4*)(Bg + (size_t)64 * K + (kt) * 64); B3 = *(const uint4*)(Bg + (size_t)96 * K + (kt) * 64); \
    A0 = *(const uint4*)(Ag + (kt) * 64); A1 = *(const uint4*)(Ag + (size_t)32 * lda + (kt) * 64); \
    if (!share) { A2 = *(const uint4*)(Ag + (size_t)64 * lda + (kt) * 64); A3 = *(const uint4*)(Ag + (size_t)96 * lda + (kt) * 64); } \
  } while (0)
#define LSTORE(A0, A1, A2, A3, B0, B1, B2, B3, buf)                                               \
  do {                                                                                            \
    u16* bs_ = Bs + (buf) * 128 * LDT + lrow; u16* as_ = As + (buf) * 128 * LDT + lrow;          \
    *(uint4*)(bs_) = B0; *(uint4*)(bs_ + 32 * LDT) = B1; *(uint4*)(bs_ + 64 * LDT) = B2; *(uint4*)(bs_ + 96 * LDT) = B3; \
    *(uint4*)(as_) = A0; *(uint4*)(as_ + 32 * LDT) = A1; if (!share) { *(uint4*)(as_ + 64 * LDT) = A2; *(uint4*)(as_ + 96 * LDT) = A3; } \
  } while (0)
#define ST0 p0, p1, p2, p3, q0, q1, q2, q3
#define ST1 r0, r1, r2, r3, t0, t1, t2, t3
#define ST2 x0, x1, x2, x3, z0, z1, z2, z3
#define GLOAD_(...) GLOAD(__VA_ARGS__)
#define LSTORE_(...) LSTORE(__VA_ARGS__)
#define COMPUTE(buf)                                                                              \
  do {                                                                                            \
    _Pragma("unroll") for (int kk = 0; kk < 2; ++kk) {                                            \
      bf16x8 af[4], wf[4];                                                                        \
      _Pragma("unroll") for (int m = 0; m < 4; ++m) af[m] = *(const bf16x8*)(afb + (buf) * 128 * LDT + (m * 16 + fr) * LDT + kk * 32 + fq * 8); \
      _Pragma("unroll") for (int n = 0; n < 4; ++n) wf[n] = *(const bf16x8*)(Bs + (buf) * 128 * LDT + (wc * 64 + n * 16 + fr) * LDT + kk * 32 + fq * 8); \
      _Pragma("unroll") for (int m = 0; m < 4; ++m)                                               \
        _Pragma("unroll") for (int n = 0; n < 4; ++n) acc[m][n] = mfma16(wf[n], af[m], acc[m][n]); \
    }                                                                                             \
  } while (0)

#define STEP(SL, SS, buf, i)                                          \
  if (kt + (i) < nk) {                                                \
    if (kt + (i) + 3 < nk) GLOAD_(SL, kt + (i) + 3);                  \
    COMPUTE(buf);                                                     \
    if (kt + (i) + 1 < nk) LSTORE_(SS, (buf) ^ 1);                    \
    __syncthreads();                                                  \
  }
  GLOAD_(ST0, 0);
  GLOAD_(ST1, 1);
  if (nk > 2) GLOAD_(ST2, 2);
  LSTORE_(ST0, 0);
  __syncthreads();
  for (int kt = 0; kt < nk; kt += 6) {
    STEP(ST0, ST1, 0, 0)
    STEP(ST1, ST2, 1, 1)
    STEP(ST2, ST0, 0, 2)
    STEP(ST0, ST1, 1, 3)
    STEP(ST1, ST2, 0, 4)
    STEP(ST2, ST0, 1, 5)
  }
#undef STEP
#undef GLOAD
#undef LSTORE
#undef COMPUTE
#undef ST0
#undef ST1
#undef ST2
#undef GLOAD_
#undef LSTORE_
  if (role > 0) {
    if (role == 2) {
#pragma unroll
      for (int m = 0; m < 4; ++m)
#pragma unroll
        for (int n = 0; n < 4; ++n) *(f32x4*)(smem + ((size_t)((m * 4 + n) * 256 + tid)) * 16) = acc[m][n];
    }
    __syncthreads();
    if (role == 2) return;
#pragma unroll
    for (int m = 0; m < 4; ++m)
#pragma unroll
      for (int n = 0; n < 4; ++n) acc[m][n] = acc[m][n] + *(const f32x4*)(smem_other + ((size_t)((m * 4 + n) * 256 + tid)) * 16);
  }

  if (dup) return;
  const int tok0 = mt * 128 + wr * 64 + fr;
  const int f0 = nt * 128 + wc * 64 + fq * 4;
  char* ws = p.ws;
  if (EPI == EPI_PROJ) {
    const bool isctx = mt >= 128;
    if (nt < 8) {
      const int grp = nt * 2 + wc; const bool isK = grp >= 8; const int gi = grp & 7, hh = gi >> 1, mp = gi & 1;
      const float* gw = (isK ? p.g_knorm : p.g_qnorm) + layer * 64;
      float gwv[4][4];
#pragma unroll
      for (int n = 0; n < 4; ++n) { const float4 t = *(const float4*)(gw + n * 16 + fq * 4); gwv[n][0] = t.x; gwv[n][1] = t.y; gwv[n][2] = t.z; gwv[n][3] = t.w; }
      const float2* rope = (const float2*)(ws + OFF_ROPE);
      const float osc = isK ? 1.f : 0.125f * LOG2E;
#pragma unroll
      for (int m = 0; m < 4; ++m) {
        const int tok = tok0 + m * 16;
        float ss = 0.f;
#pragma unroll
        for (int n = 0; n < 4; ++n)
#pragma unroll
          for (int j = 0; j < 4; ++j) ss += acc[m][n][j] * acc[m][n][j];
        ss += __shfl_xor(ss, 16); ss += __shfl_xor(ss, 32);
        const float rstd = rsqrtf(ss * (1.f / 64.f) + EPS);
        float v[4][4];
#pragma unroll
        for (int n = 0; n < 4; ++n)
#pragma unroll
          for (int j = 0; j < 4; ++j) v[n][j] = acc[m][n][j] * rstd * gwv[n][j];
        u16* dst;
        if (!isctx) {
          const int b = tok >> 13, t = tok & 8191, prow = t >> 6, pcol = t & 63;
#pragma unroll
          for (int n = 0; n < 2; ++n) {
            const float2* rp = rope + (size_t)(n == 0 ? prow : 128 + pcol) * 16 + fq * 4;
#pragma unroll
            for (int j = 0; j < 4; ++j) {
              const float2 cs = rp[j];
              const float x1 = v[n][j], x2 = v[n + 2][j];
              v[n][j] = x1 * cs.x - x2 * cs.y; v[n + 2][j] = x2 * cs.x + x1 * cs.y;
            }
          }
          if (isK) dst = (u16*)(ws + OFF_K) + ((size_t)((b * 4 + hh) * 2 + mp) * LK + 256 + t) * 64;
          else dst = (u16*)(ws + OFF_Q) + ((size_t)((b * 4 + hh) * 2 + mp) * 8192 + t) * 64;
        } else {
          const int tc = tok - XTOK, b = tc >> 8, t = tc & 255;
          if (isK) dst = (u16*)(ws + OFF_K) + ((size_t)((b * 4 + hh) * 2 + mp) * LK + t) * 64;
          else dst = (u16*)(ws + OFF_QC) + ((size_t)((b * 4 + hh) * 2 + mp) * 256 + t) * 64;
        }
#pragma unroll
        for (int n = 0; n < 4; ++n) {
          uint2 o; o.x = pk2(v[n][0] * osc, v[n][1] * osc); o.y = pk2(v[n][2] * osc, v[n][3] * osc);
          *(uint2*)(dst + n * 16 + fq * 4) = o;
        }
      }
    } else if (nt < 12) {
      const int hh = nt - 8;
      u16* vt = (u16*)(ws + OFF_VT);
#pragma unroll
      for (int m = 0; m < 4; ++m) {
        const int tok = tok0 + m * 16;
        int b, key;
        if (!isctx) { b = tok >> 13; key = 256 + (tok & 8191); } else { const int tc = tok - XTOK; b = tc >> 8; key = tc & 255; }
        const size_t base = ((size_t)(b * 4 + hh) * NKT + (key >> 5)) * 128 * 32 + (key & 31);
#pragma unroll
        for (int n = 0; n < 4; ++n)
#pragma unroll
          for (int j = 0; j < 4; ++j) { const int dv = wc * 64 + n * 16 + fq * 4 + j; vt[base + (size_t)dv * 32] = bf1(acc[m][n][j]); }
      }
    } else {
      float* dstb = (float*)(ws + (nt < 14 ? OFF_U : OFF_F));
      const int c0 = (nt & 1) * 128 + wc * 64 + fq * 4;
#pragma unroll
      for (int m = 0; m < 4; ++m) {
        const int tok = tok0 + m * 16;
#pragma unroll
        for (int n = 0; n < 4; ++n) *(f32x4*)(dstb + (size_t)tok * 256 + c0 + n * 16) = acc[m][n];
      }
    }
  } else if (EPI == EPI_OUT || EPI == EPI_FF2) {
    const float* gate = modl + (EPI == EPI_OUT ? 2048 : 5120);
    const bool last = (EPI == EPI_FF2) && (layer == DEPTH - 1);
    const float* xin = (EPI == EPI_OUT) ? xa_rd_tile(p, layer, mt) : (const float*)xb_tile(p, mt);
    float* xout = (EPI == EPI_OUT || last) ? xb_tile(p, mt) : xa_tile(p, mt);
#pragma unroll
    for (int m = 0; m < 4; ++m) {
      const int lrow = wr * 64 + m * 16 + fr;
#pragma unroll
      for (int n = 0; n < 4; ++n) {
        const int f = f0 + n * 16;
        const f32x4 gv = *(const f32x4*)(gate + f);
        f32x4 xv = *(const f32x4*)(xin + (size_t)lrow * 1024 + f);
        xv = xv + gv * acc[m][n];
        *(f32x4*)(xout + (size_t)lrow * 1024 + f) = xv;
      }
    }
  } else if (EPI == EPI_FF1) {
    u16* hid = (u16*)(ws + OFF_HID);
#pragma unroll
    for (int m = 0; m < 4; ++m) {
      const int tok = tok0 + m * 16;
#pragma unroll
      for (int n = 0; n < 4; ++n) {
        f32x4 a = acc[m][n];
#pragma unroll
        for (int j = 0; j < 4; ++j) { const float r = fmaxf(a[j], 0.f); a[j] = r * r; }
        uint2 o; o.x = pk2(a[0], a[1]); o.y = pk2(a[2], a[3]);
        *(uint2*)(hid + (size_t)tok * DFF + f0 + n * 16) = o;
      }
    }
  } else if (EPI == EPI_GLU) {
    const u16* hg = (const u16*)(ws + OFF_HGLU);
    u16* mix = (u16*)(ws + OFF_MIX);
    const float* bg = p.b_glu + layer * 256;
#pragma unroll
    for (int m = 0; m < 4; ++m) {
      const int tok = tok0 + m * 16;
#pragma unroll
      for (int n = 0; n < 4; ++n) {
        const int f = f0 + n * 16;
        const uint2 hv = *(const uint2*)(hg + (size_t)tok * 256 + f);
        const f32x4 bv = *(const f32x4*)(bg + f);
        float h[4] = {bf2f((u16)(hv.x & 0xffff)), bf2f((u16)(hv.x >> 16)), bf2f((u16)(hv.y & 0xffff)), bf2f((u16)(hv.y >> 16))};
        float o[4];
#pragma unroll
        for (int j = 0; j < 4; ++j) { const float z = acc[m][n][j] + bv[j]; o[j] = h[j] / (1.f + __expf(-z)); }
        uint2 ov; ov.x = pk2(o[0], o[1]); ov.y = pk2(o[2], o[3]);
        *(uint2*)(mix + (size_t)tok * 1024 + 512 + f) = ov;
      }
    }
  }
}

DI void attn_unit(const P& p, int layer, int u, char* smem, char* smem_o) {
  const int tid = get_tid(), lane = tid & 63, w = tid >> 6, l32 = lane & 31, hf = lane >> 5;
  char* ws = p.ws;
  int b, hh, qb, nkt, lq; const u16* Qsrc; int tokbase;
  if (u < 512) { b = u >> 8; hh = (u >> 6) & 3; qb = u & 63; nkt = NKT; lq = 8192; Qsrc = (const u16*)(ws + OFF_Q); tokbase = b * 8192 + qb * 128; }
  else { const int uu = u - 512; b = uu >> 3; hh = (uu >> 1) & 3; qb = uu & 1; nkt = 8; lq = 256; Qsrc = (const u16*)(ws + OFF_QC); tokbase = XTOK + b * 256 + qb * 128; }
  const u16* Q0 = Qsrc + ((size_t)((b * 4 + hh) * 2) * lq + qb * 128) * 64;
  const u16* K0 = (const u16*)(ws + OFF_K) + (size_t)((b * 4 + hh) * 2) * LK * 64;
  const u16* V0 = (const u16*)(ws + OFF_VT) + (size_t)(b * 4 + hh) * NKT * 4096;
  u16* Qs = (u16*)smem;
  u16* KV = Qs + 2 * 128 * LDT;
  constexpr int KVSTRIDE = 32 * LDT + 64 * 40;
  const bool hi = smem_o < smem;
  const u16* KVo = (const u16*)smem_o + 2 * 128 * LDT;
  const u16* kbase0 = hi ? KVo : KV;
  const u16* kbase1 = hi ? KV : KVo;
  const float lam = ((const float*)(ws + OFF_SMALL))[layer];
  __syncthreads();
#pragma unroll
  for (int i = 0; i < 8; ++i) {
    const int pi = tid + 256 * i;
    const int mp = pi >> 10, row = (pi >> 3) & 127, seg = pi & 7;
    *(uint4*)(Qs + (mp * 128 + row) * LDT + seg * 8) = *(const uint4*)(Q0 + (size_t)mp * lq * 64 + row * 64 + seg * 8);
  }
  uint4 kr0, vr0;
#define AGLOAD(kt)                                                                         \
  do {                                                                                     \
    kr0 = *(const uint4*)(K0 + (hi ? (size_t)LK * 64 : (size_t)0) + (size_t)(kt) * 2048 + tid * 8); \
    vr0 = *(const uint4*)(V0 + (size_t)(kt) * 4096 + (hi ? 2048 : 0) + tid * 8);           \
  } while (0)
#define ALSTORE(buf)                                                                       \
  do {                                                                                     \
    u16* kb = KV + (buf) * KVSTRIDE;                                                       \
    *(uint4*)(kb + (tid >> 3) * LDT + (tid & 7) * 8) = kr0;                                \
    u16* vb = kb + 32 * LDT;                                                               \
    *(uint4*)(vb + (tid >> 2) * 40 + (tid & 3) * 8) = vr0;                                 \
  } while (0)
  AGLOAD(0);
  ALSTORE(0);
  __syncthreads();

  f32x16 o1[4], o2[4];
#pragma unroll
  for (int i = 0; i < 4; ++i)
#pragma unroll
    for (int j = 0; j < 16; ++j) { o1[i][j] = 0.f; o2[i][j] = 0.f; }
  float l1 = 0.f, l2 = 0.f;
  const u16* qrow = Qs + (w * 32 + l32) * LDT + hf * 8;

  const bf16x8 qa0 = *(const bf16x8*)(qrow), qa1 = *(const bf16x8*)(qrow + 16);
  for (int kt = 0; kt < nkt; ++kt) {
    const int buf = kt & 1;
    if (kt + 1 < nkt) AGLOAD(kt + 1);
    const u16* kb0 = kbase0 + buf * KVSTRIDE;
    const u16* kb1 = kbase1 + buf * KVSTRIDE;
    f32x16 s1, s2;
#pragma unroll
    for (int j = 0; j < 16; ++j) { s1[j] = 0.f; s2[j] = 0.f; }
#pragma unroll
    for (int kk = 0; kk < 4; ++kk) {
      const bf16x8 kf1 = *(const bf16x8*)(kb0 + l32 * LDT + kk * 16 + hf * 8);
      s1 = mfma32(kf1, kk == 0 ? qa0 : (kk == 1 ? qa1 : *(const bf16x8*)(qrow + kk * 16)), s1);
      const bf16x8 kf2 = *(const bf16x8*)(kb1 + l32 * LDT + kk * 16 + hf * 8);
      const bf16x8 qf2 = *(const bf16x8*)(qrow + 128 * LDT + kk * 16);
      s2 = mfma32(kf2, qf2, s2);
    }
    bf16x8 pf1[2], pf2[2];
    {
      unsigned pk[8], pq[8];
#pragma unroll
      for (int j = 0; j < 8; ++j) {
        const float a0 = __builtin_amdgcn_exp2f(s1[2 * j]), a1 = __builtin_amdgcn_exp2f(s1[2 * j + 1]);
        const float c0 = __builtin_amdgcn_exp2f(s2[2 * j]), c1 = __builtin_amdgcn_exp2f(s2[2 * j + 1]);
        l1 += a0 + a1; l2 += c0 + c1;
        pk[j] = pk2(a0, a1); pq[j] = pk2(c0, c1);
      }
      typedef unsigned u32x4 __attribute__((ext_vector_type(4)));
      pf1[0] = __builtin_bit_cast(bf16x8, (u32x4){pk[0], pk[1], pk[2], pk[3]});
      pf1[1] = __builtin_bit_cast(bf16x8, (u32x4){pk[4], pk[5], pk[6], pk[7]});
      pf2[0] = __builtin_bit_cast(bf16x8, (u32x4){pq[0], pq[1], pq[2], pq[3]});
      pf2[1] = __builtin_bit_cast(bf16x8, (u32x4){pq[4], pq[5], pq[6], pq[7]});
    }
#pragma unroll
    for (int blk = 0; blk < 4; ++blk) {
#pragma unroll
      for (int s = 0; s < 2; ++s) {
        const u16* vp = (blk < 2 ? kb0 : kb1) + 32 * LDT + ((blk & 1) * 32 + l32) * 40 + 16 * s + 4 * hf;
        const uint2 lo = *(const uint2*)vp, hi = *(const uint2*)(vp + 8);
        typedef unsigned u32x4 __attribute__((ext_vector_type(4)));
        const bf16x8 vf = __builtin_bit_cast(bf16x8, (u32x4){lo.x, lo.y, hi.x, hi.y});
        o1[blk] = mfma32(vf, pf1[s], o1[blk]);
        o2[blk] = mfma32(vf, pf2[s], o2[blk]);
      }
    }
    if (kt + 1 < nkt) ALSTORE(buf ^ 1);
    __syncthreads();
  }
#undef AGLOAD
#undef ALSTORE
  l1 += __shfl_xor(l1, 32); l2 += __shfl_xor(l2, 32);
  const float i1 = 1.f / l1, i2 = lam / l2;
  float ss = 0.f;
#pragma unroll
  for (int blk = 0; blk < 4; ++blk)
#pragma unroll
    for (int j = 0; j < 16; ++j) { const float v = o1[blk][j] * i1 - o2[blk][j] * i2; o1[blk][j] = v; ss += v * v; }
  ss += __shfl_xor(ss, 32);
  const float rstd = rsqrtf(ss * (1.f / 128.f) + EPS) * (1.f - lam_init_of(layer));
  const float* gs = p.g_subln + layer * 128;
  u16* mix = (u16*)(ws + OFF_MIX) + (size_t)(tokbase + w * 32 + l32) * 1024 + hh * 128;
#pragma unroll
  for (int blk = 0; blk < 4; ++blk)
#pragma unroll
    for (int g4 = 0; g4 < 4; ++g4) {
      const int dv = blk * 32 + 8 * g4 + 4 * hf;
      const float4 gv = *(const float4*)(gs + dv);
      uint2 o;
      o.x = pk2(o1[blk][4 * g4] * rstd * gv.x, o1[blk][4 * g4 + 1] * rstd * gv.y);
      o.y = pk2(o1[blk][4 * g4 + 2] * rstd * gv.z, o1[blk][4 * g4 + 3] * rstd * gv.w);
      *(uint2*)(mix + dv) = o;
    }
}

template <bool FINAL, bool HORNER>
DI void ssm_unit(const P& p, int layer, int b, int blk, char* smem) {
  const int tid = get_tid(), lane = tid & 63, w = tid >> 6, fr = lane & 15, fq = lane >> 4;
  char* ws = p.ws;
  int tok0, cf, cr;
  if (blk < 256) { tok0 = b * 8192 + blk * 32; cf = 8 + blk; cr = 8 + 255 - blk; }
  else { const int cb = blk - 256; tok0 = XTOK + b * 256 + cb * 32; cf = cb; cr = 7 - cb; }
  u16* ub = (u16*)smem;
  float* BUw = (float*)(smem + 16896) + w * 16 * 132;
  __syncthreads();
  {
    const float4* src = (const float4*)((const float*)(ws + OFF_U) + (size_t)tok0 * 256);
#pragma unroll
    for (int i = 0; i < 8; ++i) {
      const int e = tid + 256 * i, row = e >> 6, c4 = (e & 63) * 4;
      const float4 v = src[e];
      uint2 o; o.x = pk2(v.x, v.y); o.y = pk2(v.z, v.w);
      *(uint2*)(ub + row * 264 + c4) = o;
    }
  }
  __syncthreads();
  const float2* AB = (const float2*)(ws + OFF_AB);
  const u16* BBH = (const u16*)(ws + OFF_BBH);
  const u16* CM = (const u16*)(ws + OFF_CM);
  float2* LOC = (float2*)(ws + OFF_LOCAL);
  const float2* CAR = (const float2*)(ws + OFF_CARRY);
  const bf16x8 zero8 = {0, 0, 0, 0, 0, 0, 0, 0};
  for (int gi = 0; gi < 4; ++gi) {
    const int g = w * 4 + gi;
    f32x4 y0 = (f32x4){0.f, 0.f, 0.f, 0.f}, y1 = (f32x4){0.f, 0.f, 0.f, 0.f};
#pragma unroll
    for (int dir = 0; dir < 2; ++dir) {
      const int sidx = ((layer * 2 + dir) * 16 + g) * 64 + lane;
      const float2 a = AB[sidx];
      const int chunk = dir ? cr : cf;
      const size_t cidx = ((size_t)((b * 2 + dir) * NCH + chunk) * 16 + g) * 64 + lane;
      float sr, si;
      if (FINAL && !HORNER) { const float2 c0 = CAR[cidx]; sr = c0.x; si = c0.y; }
      else { opaque_zero2(sr, si); }
      if (FINAL && HORNER) {
        const float2 aT = ((const float2*)(ws + OFF_AT))[sidx];
        const float2* lp = LOC + ((size_t)((b * 2 + dir) * NCH) * 16 + g) * 64 + lane;
        for (int c = 0; c < chunk; ++c) {
          const float2 lo = lp[(size_t)c * 1024];
          const float nr = aT.x * sr - aT.y * si + lo.x, ni = aT.x * si + aT.y * sr + lo.y;
          sr = nr; si = ni;
        }
      }
      const u16* bbp = BBH + ((size_t)((layer * 2 + dir) * 16 + g) * 128 + fr) * 16 + (fq & 1) * 8;
      const u16* cmp = CM + ((size_t)((layer * 2 + dir) * 16 + g) * 16 + fr) * 128 + fq * 8;
      bf16x8 bfr0 = *(const bf16x8*)(bbp), bfr1 = *(const bf16x8*)(bbp + 256), bfr2 = *(const bf16x8*)(bbp + 512), bfr3 = *(const bf16x8*)(bbp + 768);
      bf16x8 bfr4 = *(const bf16x8*)(bbp + 1024), bfr5 = *(const bf16x8*)(bbp + 1280), bfr6 = *(const bf16x8*)(bbp + 1536), bfr7 = *(const bf16x8*)(bbp + 1792);
      if (fq >= 2) { bfr0 = zero8; bfr1 = zero8; bfr2 = zero8; bfr3 = zero8; bfr4 = zero8; bfr5 = zero8; bfr6 = zero8; bfr7 = zero8; }
      bf16x8 cf0 = zero8, cf1 = zero8, cf2 = zero8, cf3 = zero8;
      if (FINAL) { cf0 = *(const bf16x8*)(cmp); cf1 = *(const bf16x8*)(cmp + 32); cf2 = *(const bf16x8*)(cmp + 64); cf3 = *(const bf16x8*)(cmp + 96); }
#pragma unroll
      for (int hh = 0; hh < 2; ++hh) {
        const int tb = dir ? 1 - hh : hh;
        {
          const bf16x8 ufl = *(const bf16x8*)(ub + (tb * 16 + fr) * 264 + g * 16 + (fq & 1) * 8);
          const bf16x8 uf = fq < 2 ? ufl : zero8;
#define BU_(CBI, BF) do { const f32x4 d = mfma16(BF, uf, (f32x4){0.f, 0.f, 0.f, 0.f}); *(f32x4*)(BUw + fr * 132 + (CBI) * 16 + fq * 4) = d; } while (0)
          BU_(0, bfr0); BU_(1, bfr1); BU_(2, bfr2); BU_(3, bfr3); BU_(4, bfr4); BU_(5, bfr5); BU_(6, bfr6); BU_(7, bfr7);
#undef BU_
        }
        __syncthreads();
#pragma unroll 4
        for (int tt = 0; tt < 16; ++tt) {
          const int tl = dir ? 15 - tt : tt;
          const float2 bu = *(const float2*)(BUw + tl * 132 + 2 * lane);
          const float nr = a.x * sr - a.y * si + bu.x, ni = a.x * si + a.y * sr + bu.y;
          sr = nr; si = ni;
          if (FINAL) { u16* srow = (u16*)(BUw + tl * 132); srow[lane] = bf1(sr); srow[64 + lane] = bf1(si); }
        }
        __syncthreads();
        if (FINAL) {
          f32x4 yy = tb == 0 ? y0 : y1;
          const u16* sp = (const u16*)(BUw + fr * 132) + fq * 8;
          yy = mfma16(cf0, *(const bf16x8*)(sp), yy);
          yy = mfma16(cf1, *(const bf16x8*)(sp + 32), yy);
          yy = mfma16(cf2, *(const bf16x8*)(sp + 64), yy);
          yy = mfma16(cf3, *(const bf16x8*)(sp + 96), yy);
          if (tb == 0) y0 = yy; else y1 = yy;
          __syncthreads();
        }
      }
      if (!FINAL) LOC[cidx] = make_float2(sr, si);
    }
    if (FINAL) {
      const int ch = g * 16 + fq * 4;
      const float4 dsk = *(const float4*)(p.ssm_d + layer * 256 + ch);
      u16* hg = (u16*)(ws + OFF_HGLU);
#pragma unroll
      for (int tb = 0; tb < 2; ++tb) {
        const int t = tb * 16 + fr;
        const f32x4 yv = tb == 0 ? y0 : y1;
        const uint2 uraw = *(const uint2*)(ub + t * 264 + ch);
        const float u0 = bf2f((u16)(uraw.x & 0xffff)), u1 = bf2f((u16)(uraw.x >> 16)), u2 = bf2f((u16)(uraw.y & 0xffff)), u3 = bf2f((u16)(uraw.y >> 16));
        const float r0 = gelu_tanh(yv[0] + dsk.x * u0), r1 = gelu_tanh(yv[1] + dsk.y * u1);
        const float r2 = gelu_tanh(yv[2] + dsk.z * u2), r3 = gelu_tanh(yv[3] + dsk.w * u3);
        uint2 o; o.x = pk2(r0, r1); o.y = pk2(r2, r3);
        *(uint2*)(hg + (size_t)(tok0 + t) * 256 + ch) = o;
      }
    }
  }
}

DI void ssm_carry_unit(const P& p, int layer, int u, char* smem) {
  const int tid = get_tid(), seg = tid >> 5, sl = tid & 31;
  const int st = u * 32 + sl;
  const int gn = st & 1023, bd = st >> 10, dir = bd & 1;
  float2* tot = (float2*)smem;
  const float2 aT = ((const float2*)(p.ws + OFF_AT))[((layer * 2 + dir) * 1024) + gn];
  const float2* LOC = (const float2*)(p.ws + OFF_LOCAL) + (size_t)bd * NCH * 1024 + gn + (size_t)seg * 33 * 1024;
  float2* CAR = (float2*)(p.ws + OFF_CARRY) + (size_t)bd * NCH * 1024 + gn + (size_t)seg * 33 * 1024;
  __syncthreads();
  float sr, si;
  opaque_zero2(sr, si);
  float pr = 1.f, pi = 0.f;
#pragma unroll 11
  for (int j = 0; j < 33; ++j) {
    const float2 lo = LOC[(size_t)j * 1024];
    const float nr = aT.x * sr - aT.y * si + lo.x, ni = aT.x * si + aT.y * sr + lo.y;
    sr = nr; si = ni;
    const float qr = pr * aT.x - pi * aT.y, qi = pr * aT.y + pi * aT.x;
    pr = qr; pi = qi;
  }
  tot[seg * 32 + sl] = make_float2(sr, si);
  __syncthreads();
  opaque_zero2(sr, si);
  for (int k = 0; k < seg; ++k) {
    const float2 t = tot[k * 32 + sl];
    const float nr = pr * sr - pi * si + t.x, ni = pr * si + pi * sr + t.y;
    sr = nr; si = ni;
  }
#pragma unroll 11
  for (int j = 0; j < 33; ++j) {
    CAR[(size_t)j * 1024] = make_float2(sr, si);
    const float2 lo = LOC[(size_t)j * 1024];
    const float nr = aT.x * sr - aT.y * si + lo.x, ni = aT.x * si + aT.y * sr + lo.y;
    sr = nr; si = ni;
  }
}

DI void fft1_unit(const P& p, int u, char* smem) {
  const int tid = get_tid(), lane = tid & 63, w = tid >> 6, fr = lane & 15, fq = lane >> 4;
  const int b = u >> 8, col = (u >> 2) & 63, g = u & 3;
  u16* Ht = (u16*)smem;
  __syncthreads();
  const float* F = (const float*)(p.ws + OFF_F);
#pragma unroll
  for (int i = 0; i < 8; ++i) {
    const int r = (tid >> 4) + 16 * i, c4 = (tid & 15) * 4;
    const float4 v = *(const float4*)(F + (size_t)(b * 8192 + 64 * r + col) * 256 + g * 64 + c4);
    Ht[(c4 + 0) * 136 + r] = bf1(v.x); Ht[(c4 + 1) * 136 + r] = bf1(v.y); Ht[(c4 + 2) * 136 + r] = bf1(v.z); Ht[(c4 + 3) * 136 + r] = bf1(v.w);
  }
  __syncthreads();
  f32x4 acc[4][4];
#pragma unroll
  for (int n = 0; n < 4; ++n)
#pragma unroll
    for (int m = 0; m < 4; ++m) acc[n][m] = (f32x4){0.f, 0.f, 0.f, 0.f};
  const u16* D = (const u16*)(p.ws + OFF_D128);
#pragma unroll
  for (int kk = 0; kk < 4; ++kk) {
    bf16x8 hfv[4], df[4];
#pragma unroll
    for (int n = 0; n < 4; ++n) hfv[n] = *(const bf16x8*)(Ht + (n * 16 + fr) * 136 + kk * 32 + fq * 8);
#pragma unroll
    for (int m = 0; m < 4; ++m) df[m] = *(const bf16x8*)(D + (size_t)(64 * w + 16 * m + fr) * 128 + kk * 32 + fq * 8);
#pragma unroll
    for (int n = 0; n < 4; ++n)
#pragma unroll
      for (int m = 0; m < 4; ++m) acc[n][m] = mfma16(hfv[n], df[m], acc[n][m]);
  }
  float* T = (float*)(p.ws + OFF_T);
#pragma unroll
  for (int m = 0; m < 4; ++m) {
    const int dr = 64 * w + 16 * m + fr, ri = dr >> 7, k1 = dr & 127;
    float* dst = T + ((size_t)(((b * 4 + g) * 128 + k1) * 2 + ri) * 64 + col) * 64;
#pragma unroll
    for (int n = 0; n < 4; ++n) *(f32x4*)(dst + n * 16 + fq * 4) = acc[n][m];
  }
}

DI void fft2_unit(const P& p, int layer, int u, char* smem) {
  const int tid = get_tid(), lane = tid & 63, w = tid >> 6, fr = lane & 15, fq = lane >> 4;
  const int b = u >> 9, k1 = (u >> 2) & 127, g = u & 3;
  u16* Xt = (u16*)smem;
  u16* Gt = Xt + 64 * 136;
  __syncthreads();
  const float* T = (const float*)(p.ws + OFF_T) + (size_t)(((b * 4 + g) * 128 + k1) * 2) * 4096;
  const float2* TW = (const float2*)(p.ws + OFF_TW) + k1 * 64;
#pragma unroll
  for (int i = 0; i < 4; ++i) {
    const int col = (tid >> 4) + 16 * i, c4 = (tid & 15) * 4;
    const float4 re = *(const float4*)(T + col * 64 + c4), im = *(const float4*)(T + 4096 + col * 64 + c4);
    const float2 tw = TW[col];
    const float rr[4] = {re.x, re.y, re.z, re.w}, ii[4] = {im.x, im.y, im.z, im.w};
#pragma unroll
    for (int e = 0; e < 4; ++e) {
      Xt[(c4 + e) * 136 + col] = bf1(rr[e] * tw.x - ii[e] * tw.y);
      Xt[(c4 + e) * 136 + 64 + col] = bf1(rr[e] * tw.y + ii[e] * tw.x);
    }
  }
  __syncthreads();
  {
    f32x4 acc[4][2];
#pragma unroll
    for (int n = 0; n < 4; ++n) { acc[n][0] = (f32x4){0.f, 0.f, 0.f, 0.f}; acc[n][1] = (f32x4){0.f, 0.f, 0.f, 0.f}; }
    const u16* D = (const u16*)(p.ws + OFF_D64);
#pragma unroll
    for (int kk = 0; kk < 4; ++kk) {
      bf16x8 xf[4], df[2];
#pragma unroll
      for (int n = 0; n < 4; ++n) xf[n] = *(const bf16x8*)(Xt + (n * 16 + fr) * 136 + kk * 32 + fq * 8);
#pragma unroll
      for (int m = 0; m < 2; ++m) df[m] = *(const bf16x8*)(D + (size_t)(32 * w + 16 * m + fr) * 128 + kk * 32 + fq * 8);
#pragma unroll
      for (int n = 0; n < 4; ++n)
#pragma unroll
        for (int m = 0; m < 2; ++m) acc[n][m] = mfma16(xf[n], df[m], acc[n][m]);
    }
#pragma unroll
    for (int m = 0; m < 2; ++m) {
      const int row2 = 32 * w + 16 * m + fr, ri = row2 >> 6, k2 = row2 & 63;
#pragma unroll
      for (int n = 0; n < 4; ++n) {
        uint2 o; o.x = pk2(acc[n][m][0], acc[n][m][1]); o.y = pk2(acc[n][m][2], acc[n][m][3]);
        *(uint2*)(Gt + k2 * 136 + ri * 64 + n * 16 + fq * 4) = o;
      }
    }
  }
  __syncthreads();
  {
    f32x4 acc[4];
#pragma unroll
    for (int n = 0; n < 4; ++n) acc[n] = (f32x4){0.f, 0.f, 0.f, 0.f};
    const u16* W = (const u16*)(p.ws + OFF_WCS) + (size_t)(layer * 4 + g) * 64 * 128;
#pragma unroll
    for (int kk = 0; kk < 4; ++kk) {
      const bf16x8 gf = *(const bf16x8*)(Gt + (16 * w + fr) * 136 + kk * 32 + fq * 8);
#pragma unroll
      for (int n = 0; n < 4; ++n) {
        const bf16x8 wf = *(const bf16x8*)(W + (size_t)(n * 16 + fr) * 128 + kk * 32 + fq * 8);
        acc[n] = mfma16(wf, gf, acc[n]);
      }
    }
    const int k2 = 16 * w + fr;
    u16* mix = (u16*)(p.ws + OFF_MIX) + (size_t)(b * 8192 + k1 + 128 * k2) * 1024 + 768 + g * 64;
#pragma unroll
    for (int n = 0; n < 4; ++n) {
      uint2 o; o.x = pk2(acc[n][0], acc[n][1]); o.y = pk2(acc[n][2], acc[n][3]);
      *(uint2*)(mix + n * 16 + fq * 4) = o;
    }
  }
}

DI void ctxfft_unit(const P& p, int layer, int u, char* smem) {
  const int tid = get_tid();
  const int b = u >> 6, g = (u >> 4) & 3, kb = u & 15;
  float2* tab = (float2*)smem;
  float* Gs = (float*)(smem + 2048);
  float* zs = Gs + 16 * 128;
  __syncthreads();
  { const float ang = 6.283185307179586f * (float)tid / 256.f; tab[tid] = make_float2(cosf(ang), sinf(ang)); }
  __syncthreads();
  const int kl = tid >> 4, c4 = (tid & 15) * 4, k = kb * 16 + kl;
  const float* F = (const float*)(p.ws + OFF_F) + (size_t)(XTOK + b * 256) * 256 + g * 64 + c4;
  float gr[4] = {0.f, 0.f, 0.f, 0.f}, gim[4] = {0.f, 0.f, 0.f, 0.f};
#pragma unroll 16
  for (int l = 0; l < 256; ++l) {
    const float4 hv = *(const float4*)(F + (size_t)l * 256);
    const float2 cs = tab[(k * l) & 255];
    gr[0] += cs.x * hv.x; gr[1] += cs.x * hv.y; gr[2] += cs.x * hv.z; gr[3] += cs.x * hv.w;
    gim[0] -= cs.y * hv.x; gim[1] -= cs.y * hv.y; gim[2] -= cs.y * hv.z; gim[3] -= cs.y * hv.w;
  }
#pragma unroll
  for (int e = 0; e < 4; ++e) { Gs[kl * 128 + c4 + e] = gr[e]; Gs[kl * 128 + 64 + c4 + e] = gim[e]; }
  __syncthreads();
  float z[4] = {0.f, 0.f, 0.f, 0.f};
  for (int c = 0; c < 64; ++c) {
    const float a = Gs[kl * 128 + c], bi = Gs[kl * 128 + 64 + c];
#pragma unroll
    for (int e = 0; e < 4; ++e) { const float2 cs = tab[((c * (c4 + e)) & 63) * 4]; z[e] += a * cs.x + bi * cs.y; }
  }
#pragma unroll
  for (int e = 0; e < 4; ++e) zs[kl * 64 + c4 + e] = z[e] * (1.f / 128.f);
  __syncthreads();
  const float* wf = p.w_fnet + (size_t)(layer * 4 + g) * 4096;
  float o[4] = {0.f, 0.f, 0.f, 0.f};
  for (int cp = 0; cp < 64; ++cp) {
    const float zv = zs[kl * 64 + cp];
    const float4 wv = *(const float4*)(wf + cp * 64 + c4);
    o[0] += zv * wv.x; o[1] += zv * wv.y; o[2] += zv * wv.z; o[3] += zv * wv.w;
  }
  u16* mix = (u16*)(p.ws + OFF_MIX) + (size_t)(XTOK + b * 256 + k) * 1024 + 768 + g * 64 + c4;
  uint2 ov; ov.x = pk2(o[0], o[1]); ov.y = pk2(o[2], o[3]);
  *(uint2*)mix = ov;
}


#define XB_TMO      128
#define XB_XCNT(j)  (256  + 64 * (j))
#define XB_XSUB(j)  (1280 + 64 * (j))
#define XB_XGEN(j)  (2304 + 64 * (j))
#define XB_TOP      3328
#define XB_TOPGEN   3392
#define XB_SPIN_CAP (1u << 18)
#define LAS __attribute__((address_space(3)))
DI unsigned xb_ld(unsigned* q) { return __hip_atomic_load(q, __ATOMIC_RELAXED, __HIP_MEMORY_SCOPE_AGENT); }
DI unsigned xb_add(unsigned* q, unsigned v) { return __hip_atomic_fetch_add(q, v, __ATOMIC_RELAXED, __HIP_MEMORY_SCOPE_AGENT); }
DI unsigned xb_xcc_id() { return (unsigned)__builtin_amdgcn_s_getreg((3 << 11) | 20) & 0xFu; }
#define XB_SPIN(cond, bar) do { unsigned _sp = 0; while (cond) { __builtin_amdgcn_s_sleep(1); \
    if ((++_sp & 255u) == 0u) { if (xb_ld(&(bar)[XB_TMO])) break; if (_sp > XB_SPIN_CAP) { atomicAdd(&(bar)[XB_TMO], 1u); break; } } } } while (0)
struct XcdBarrier { unsigned* bar; unsigned x; volatile LAS unsigned* st; };
DI XcdBarrier xcd_barrier_post(unsigned* bar, volatile LAS unsigned* st) {
  XcdBarrier b; b.bar = bar; b.x = xb_xcc_id(); b.st = st;
  if (threadIdx.x == 0) (void)xb_add(&bar[XB_XCNT(b.x)], 1u);
  return b;
}
DI void xcd_barrier_complete(unsigned* bar, unsigned x, unsigned& nloc, unsigned& nx) {
  const unsigned G = gridDim.x * gridDim.y * gridDim.z;
  unsigned sum, cnt, mine, sp = 0u;
  for (;;) {
    sum = 0u; cnt = 0u; mine = 0u;
#pragma unroll
    for (unsigned j = 0; j < 16; ++j) { const unsigned c = xb_ld(&bar[XB_XCNT(j)]); sum += c; cnt += (c > 0u) ? 1u : 0u; mine = (j == x) ? c : mine; }
    if (sum == G) break;
    __builtin_amdgcn_s_sleep(1);
    if ((++sp & 255u) == 0u) { if (xb_ld(&bar[XB_TMO])) break; if (sp > XB_SPIN_CAP) { atomicAdd(&bar[XB_TMO], 1u); break; } }
  }
  nloc = mine > 0u ? mine : 1u; nx = cnt > 0u ? cnt : 1u;
}
DI void xcd_barrier(const XcdBarrier& b) {
  asm volatile("s_waitcnt vmcnt(0)" ::: "memory");
  __syncthreads();
  if (threadIdx.x == 0) {
    unsigned* bar = b.bar;
    __builtin_amdgcn_s_waitcnt(0);
    unsigned nloc = b.st[0], nx = b.st[1];
    if (nloc == 0u) { xcd_barrier_complete(bar, b.x, nloc, nx); b.st[0] = nloc; b.st[1] = nx; }
    const unsigned old = xb_add(&bar[XB_XSUB(b.x)], 1u);
    const unsigned gen = old / nloc;
    if (old + 1u == (gen + 1u) * nloc) {
      __builtin_amdgcn_fence(__ATOMIC_RELEASE, "agent");
      asm volatile("s_waitcnt vmcnt(0)" ::: "memory");
      const unsigned og = xb_add(&bar[XB_TOP], 1u);
      const unsigned tg = og / nx;
      if (og + 1u == (tg + 1u) * nx) xb_add(&bar[XB_TOPGEN], 1u);
      else XB_SPIN(xb_ld(&bar[XB_TOPGEN]) == tg, bar);
      __builtin_amdgcn_fence(__ATOMIC_ACQUIRE, "agent");
      xb_add(&bar[XB_XGEN(b.x)], 1u);
      asm volatile("s_waitcnt vmcnt(0)" ::: "memory");
    } else {
      XB_SPIN(xb_ld(&bar[XB_XGEN(b.x)]) == gen, bar);
      __builtin_amdgcn_fence(__ATOMIC_ACQUIRE, "agent");
      asm volatile("s_waitcnt vmcnt(0)" ::: "memory");
    }
  }
  __syncthreads();
}

constexpr int NSUB = 10;
constexpr int NPHASE = 1 + DEPTH * NSUB;
DI int sub_of(int i) { return (int)((0x76d54983ba210cULL >> (4 * i)) & 15ULL); }

#define LOOPB(N, ROT, ...) do { const int n_ = (N); int br_ = B - (ROT); if (br_ < 0) br_ += G; \
    for (int u0_ = br_ & ~1; u0_ < n_; u0_ += G) { int u = u0_ + (br_ & 1); const bool dup = u >= n_; if (dup) u = n_ - 1; __VA_ARGS__; } } while (0)
#define LOOPG(N, NT, CALL) do { const int n_ = (N); const int full_ = (n_ / G) * G; const int rem_ = n_ - full_; \
    for (int ub_ = B; ub_ < full_; ub_ += G) { int u = ub_; \
      if (G == 512) {   \
        const int it_ = ub_ >> 9, w_ = B >> 1, x_ = w_ & 7, j_ = w_ >> 3, ng_ = (NT) >> 3; \
        u = ((512 / (NT)) * it_ + (x_ / ng_) * 8 + (j_ >> 2)) * (NT) + (x_ % ng_) * 8 + (j_ & 3) * 2 + (B & 1); } \
      CALL(u, false, 0); } \
    if (rem_ > 0) { \
      if (rem_ * 2 <= G) { const int wg_ = B >> 1; if (wg_ < rem_) { CALL(full_ + wg_, false, (B & 1) + 1); } } \
      else { const int u0_ = full_ + (B & ~1); if (u0_ < n_) { int u = u0_ + (B & 1); const bool dup = u >= n_; if (dup) u = n_ - 1; CALL(u, dup, -1); } } \
    } } while (0)
#define LOOPN(N, ROT, ...) do { const int n_ = (N); int br_ = B - (ROT); if (br_ < 0) br_ += G; \
    for (int u = br_; u < n_; u += G) { __VA_ARGS__; } } while (0)

DI void run_phase(const P& p, int ph, char* smem) {
  const int G = gridDim.x * 2, B = blockIdx.x * 2 + __builtin_amdgcn_readfirstlane(threadIdx.x >> 8);
  char* ws = p.ws;
  char* smem_o = (B & 1) ? smem - LDS_BYTES : smem + LDS_BYTES;
  if (ph == 0) {
    LOOPB(11328, 0, prep_transposes(p, u, smem));
    LOOPB(384, 0, prep_mod(p, u, smem));
    LOOPN(32, 384, prep_disc(p, u));
    LOOPN(N_TABLE_UNITS, 0, prep_tables(p, u));
    LOOPN(512, 0, prep_wcs(p, u));
    LOOPN(1024, 0, prep_cm(p, u));
    return;
  }
  const int layer = (ph - 1) / NSUB, sub = (ph - 1) % NSUB;
  const bool lastl = layer == DEPTH - 1;
  const int nmt = lastl ? 128 : 132;
  switch (sub) {
    case 0: LOOPN(2112, 0, norm_unit(p, layer, 0, u)); break;
    case 1: {
      const u16* Wt = (const u16*)(ws + OFF_WIN) + (size_t)layer * 2048 * 1024;
#define CALL_(u, dup, role) gemm_unit<1, EPI_PROJ>(p, layer, (u) >> 4, (u) & 15, 1024, Wt, ws + OFF_HN, 1024, nullptr, nullptr, nullptr, smem, dup, role, smem_o)
      LOOPG(132 * 16, 16, CALL_);
#undef CALL_
    } break;
    case 2: {
      LOOPB(512, 0, (ssm_unit<false, false>(p, layer, u >> 8, u & 255, smem)));
      LOOPB(16, 0, (ssm_unit<false, false>(p, layer, u >> 3, 256 + (u & 7), smem)));
      LOOPB(512, 0, fft1_unit(p, u, smem));
      if (!lastl) LOOPB(128, 16, ctxfft_unit(p, layer, u, smem));
    } break;
    case 3: {
      LOOPB(128, 0, ssm_carry_unit(p, layer, u, smem));
      if (!lastl) LOOPB(16, 128, (ssm_unit<true, true>(p, layer, u >> 3, 256 + (u & 7), smem)));
      if (!lastl) LOOPB(16, 144, attn_unit(p, layer, 512 + u, smem, smem_o));
      LOOPB(1024, 0, fft2_unit(p, layer, u, smem));
    } break;
    case 4: {
      LOOPB(512, 0, attn_unit(p, layer, (G == 512 ? ((((u >> 1) & 7) << 6) | ((u >> 4) << 1) | (u & 1)) : u), smem, smem_o));
      LOOPB(512, 0, (ssm_unit<true, false>(p, layer, u >> 8, u & 255, smem)));
    } break;
    case 5: {
      const u16* Wt = (const u16*)(ws + OFF_WGLU) + (size_t)layer * 256 * 256;
      LOOPB(nmt * 2, 0, (gemm_unit<1, EPI_GLU>(p, layer, u >> 1, u & 1, 256, Wt, ws + OFF_HGLU, 256, nullptr, nullptr, nullptr, smem, dup)));
    } break;
    case 6: {
      const u16* Wt = (const u16*)(ws + OFF_WOUT) + (size_t)layer * 1024 * 1024;
#define CALL_(u, dup, role) gemm_unit<1, EPI_OUT>(p, layer, (u) >> 3, (u) & 7, 1024, Wt, ws + OFF_MIX, 1024, nullptr, nullptr, nullptr, smem, dup, role, smem_o)
      LOOPG(nmt * 8, 8, CALL_);
#undef CALL_
    } break;
    case 7: LOOPN(nmt * 16, 0, norm_unit(p, layer, 1, u)); break;
    case 8: {
      const u16* Wt = (const u16*)(ws + OFF_WFF1) + (size_t)layer * 4096 * 1024;
#define CALL_(u, dup, role) gemm_unit<1, EPI_FF1>(p, layer, (u) >> 5, (u) & 31, 1024, Wt, ws + OFF_HN, 1024, nullptr, nullptr, nullptr, smem, dup, role, smem_o)
      LOOPG(nmt * 32, 32, CALL_);
#undef CALL_
    } break;
    case 9: {
      const u16* Wt = (const u16*)(ws + OFF_WFF2) + (size_t)layer * 1024 * 4096;
#define CALL_(u, dup, role) gemm_unit<1, EPI_FF2>(p, layer, (u) >> 3, (u) & 7, 4096, Wt, ws + OFF_HID, 4096, nullptr, nullptr, nullptr, smem, dup, role, smem_o)
      LOOPG(nmt * 8, 8, CALL_);
#undef CALL_
    } break;
  }
}

__global__ void __launch_bounds__(512) mega(P p, int ph_lo, int ph_hi, int coop) {
  __shared__ __attribute__((aligned(16))) char smem_all[2 * LDS_BYTES];
  __shared__ uint4 xb_words;
  char* smem = smem_all + __builtin_amdgcn_readfirstlane(threadIdx.x >> 8) * LDS_BYTES;
  if (threadIdx.x == 0) xb_words = make_uint4(0u, 0u, 0u, 0u);
  __syncthreads();
  XcdBarrier xb = xcd_barrier_post((unsigned*)(p.ws + OFF_BAR), (volatile LAS unsigned*)&xb_words);
  for (int ph = ph_lo; ph < ph_hi; ++ph) {
    P q = p;
    asm volatile("" : "+s"(q.ws));
    run_phase(q, ph, smem);
    if (coop && ph + 1 < ph_hi) {
      if (ph == ph_lo) {
        asm volatile("s_waitcnt vmcnt(0)" ::: "memory");
        cg::this_grid().sync();
        if (threadIdx.x < 64) {
          __builtin_amdgcn_fence(__ATOMIC_ACQUIRE, "agent");
          asm volatile("s_waitcnt vmcnt(0)" ::: "memory");
        }
        __syncthreads();
      } else {
        xcd_barrier(xb);
      }
    }
  }
}

#ifdef DBG_DUMP
__global__ void __launch_bounds__(256) dumpk(P p) {
  const size_t n = (size_t)XTOK * 1024;
  for (size_t i = (size_t)blockIdx.x * 256 + threadIdx.x; i < n; i += (size_t)gridDim.x * 256) {
#if DBG_DUMP == 0
    { const int cc = (int)(i & 1023); p.out[i] = (cc >= DBG_CLO && cc < DBG_CHI) ? bf2f(((const u16*)(p.ws + OFF_MIX))[i]) : 0.f; }
#elif DBG_DUMP == 8
    p.out[i] = i < (size_t)512 * 1024 ? bf2f(((const u16*)(p.ws + OFF_MIX))[(size_t)XTOK * 1024 + i]) : 0.f;
#elif DBG_DUMP == 9
    p.out[i] = i < (size_t)512 * 1024 ? ((const float*)(p.ws + OFF_XBUF))[(size_t)XTOK * 1024 + i] : 0.f;
#elif DBG_DUMP == 10
    p.out[i] = ((const float*)(p.ws + OFF_T))[i % ((size_t)8388608)];
#elif DBG_DUMP == 11
    p.out[i] = bf2f(((const u16*)(p.ws + OFF_WIN))[(size_t)3 * 2048 * 1024 + (i % ((size_t)2048 * 1024))]);
#elif DBG_DUMP == 13
    p.out[i] = bf2f(((const u16*)(p.ws + OFF_WIN))[(size_t)3 * 2048 * 1024 + (i % ((size_t)2048 * 1024))]) + ((const float*)(p.ws + OFF_MOD))[i % ((size_t)4 * 3 * 6144)];
#elif DBG_DUMP == 12
    p.out[i] = ((const float*)(p.ws + OFF_MOD))[i % ((size_t)4 * 3 * 6144)];
#elif DBG_DUMP == 1
    p.out[i] = ((const float*)(p.ws + OFF_XBUF))[i];
#elif DBG_DUMP == 2
    p.out[i] = bf2f(((const u16*)(p.ws + OFF_Q))[i % ((size_t)2*4*2*8192*64)]) + bf2f(((const u16*)(p.ws + OFF_K))[i % ((size_t)2*4*2*8448*64)]) + bf2f(((const u16*)(p.ws + OFF_VT))[i % ((size_t)2*4*8448*128)]);
#elif DBG_DUMP == 3
    p.out[i] = ((const float*)(p.ws + OFF_U))[i % ((size_t)NTOK*256)] + ((const float*)(p.ws + OFF_F))[i % ((size_t)NTOK*256)];
#elif DBG_DUMP == 4
    p.out[i] = bf2f(((const u16*)(p.ws + OFF_HGLU))[i % ((size_t)NTOK*256)]);
#endif
  }
}
#endif

extern "C" void kernel_launch(void* const* d_in, const int* in_sizes, int n_in, void* d_out, int out_size, void* d_ws, size_t ws_size,
                              hipStream_t stream) {
  static int grid_blocks = 0;
  if (!grid_blocks) {
    int dev = 0, cus = 0, per_cu = 0;
    hipGetDevice(&dev);
    hipDeviceGetAttribute(&cus, hipDeviceAttributeMultiprocessorCount, dev);
    hipOccupancyMaxActiveBlocksPerMultiprocessor(&per_cu, mega, 512, 0);
    if (per_cu < 1) per_cu = 1;
    if (per_cu > 1) per_cu = 1;
    grid_blocks = cus * per_cu;
  }
  if (ws_size < WS_NEED) { fprintf(stderr, "workspace too small: %zu < %zu\n", ws_size, (size_t)WS_NEED); return; }
  P p{};
  const float** pp = (const float**)&p;
  for (int i = 0; i < 30; ++i) pp[i] = (const float*)d_in[i];
  p.out = (float*)d_out;
  p.ws = (char*)d_ws;
#ifdef DBG_MEMSET
  hipMemsetAsync(d_ws, 0, WS_NEED, stream);
#endif
  hipMemsetAsync((char*)d_ws + OFF_BAR, 0, BAR_BYTES, stream);
#if COOP
#ifdef DBG_STOP
  int lo = 0, hi = DBG_STOP, coop = 1;
#else
  int lo = 0, hi = NPHASE, coop = 1;
#endif
  void* args[] = {&p, &lo, &hi, &coop};
  hipError_t e = hipLaunchCooperativeKernel((void*)mega, dim3(grid_blocks), dim3(512), args, 0, stream);
  if (e != hipSuccess) fprintf(stderr, "cooperative launch failed: %s (grid %d)\n", hipGetErrorString(e), grid_blocks);
#ifdef DBG_DUMP
  dumpk<<<dim3(1024), dim3(256), 0, stream>>>(p);
#endif
#else
#ifdef DBG_STOP
  for (int ph = 0; ph < DBG_STOP; ++ph) mega<<<dim3(grid_blocks), dim3(512), 0, stream>>>(p, ph, ph + 1, 0);
#else
  for (int ph = 0; ph < NPHASE; ++ph) mega<<<dim3(grid_blocks), dim3(512), 0, stream>>>(p, ph, ph + 1, 0);
#endif
#ifdef DBG_DUMP
  dumpk<<<dim3(1024), dim3(256), 0, stream>>>(p);
#endif
#endif
}
```
